# Optimizing an MI355X kernel written in HIP

```python
import jax
import jax.numpy as jnp
from jax import lax
import numpy as np

D_MODEL = 1024
BATCH = 16
SEQ = 2048
DEPTH = 1

GLA_HEADS = 4
GLA_DK = 64
GLA_DV = 128
GLA_RANK = 16
GLA_TAU = 16.0
GLA_CHUNK = 64
NSA_HEADS = 4
NSA_KV_HEADS = 2
NSA_DH = 128
NSA_BRANCHES = 3
CMP_BLOCK = 32
CMP_STRIDE = 16
CMP_HIDDEN = 256
SEL_BLOCK = 64
SEL_TOPK = 16
SEL_QBLK = 16
WINDOW = 512
WIN_QBLK = 128
D_FF = 4 * D_MODEL
N_MOD = 6
ROPE_THETA = 10000.0
EPS = 1e-6
NEG = -1e30
BIG = 1e30

GLA_WIDTH = GLA_HEADS * GLA_DV
NSA_WIDTH = NSA_HEADS * NSA_DH
NSA_KV_WIDTH = NSA_KV_HEADS * NSA_DH
IN_SPLITS = (GLA_HEADS * GLA_DK, GLA_HEADS * GLA_DK, GLA_WIDTH, GLA_WIDTH, GLA_RANK,
             NSA_WIDTH, NSA_KV_WIDTH, NSA_KV_WIDTH, NSA_KV_WIDTH, NSA_KV_WIDTH,
             NSA_KV_WIDTH, NSA_KV_WIDTH, NSA_HEADS * NSA_BRANCHES)
D_IN = sum(IN_SPLITS)

kernel_name = 'hybrid_gla_nsa_adaln_block'


def rms_norm(x, g):
    xf = x.astype(jnp.float32)
    y = xf * lax.rsqrt(jnp.mean(xf * xf, axis=-1, keepdims=True) + EPS)
    return (y * g.astype(jnp.float32)).astype(x.dtype)


def rope(x, pos):
    half = x.shape[-1] // 2
    inv = ROPE_THETA ** (-jnp.arange(half, dtype=jnp.float32) / half)
    ang = pos.astype(jnp.float32)[..., None] * inv
    cos = jnp.cos(ang)[:, :, None, :]
    sin = jnp.sin(ang)[:, :, None, :]
    xf = x.astype(jnp.float32)
    x1, x2 = xf[..., :half], xf[..., half:]
    return jnp.concatenate([x1 * cos - x2 * sin, x2 * cos + x1 * sin], axis=-1).astype(x.dtype)


def masked_softmax(s, mask):
    return jax.nn.softmax(jnp.where(mask, s.astype(jnp.float32), NEG), axis=-1)


def gla_chunked(q, k, v, log_a):
    B, S, H, dk = q.shape
    dv = v.shape[-1]
    C = GLA_CHUNK
    N = S // C

    def blocks(t):
        return t.astype(jnp.float32).reshape(B, N, C, H, t.shape[-1]).transpose(0, 3, 1, 2, 4)

    qf = blocks(q) * dk ** -0.5
    kf, vf, la = blocks(k), blocks(v), blocks(log_a)
    b = jnp.cumsum(la, axis=3)
    b_last = b[:, :, :, -1:, :]
    q_in = qf * jnp.exp(b)
    k_in = kf * jnp.exp(-b)
    causal = jnp.tril(jnp.ones((C, C), dtype=bool))
    att = jnp.where(causal, jnp.einsum('bhncd,bhnsd->bhncs', q_in, k_in), 0.0)
    o_intra = jnp.einsum('bhncs,bhnse->bhnce', att, vf)
    d_state = jnp.einsum('bhncd,bhnce->bhnde', kf * jnp.exp(b_last - b), vf)
    decay = jnp.exp(b_last[:, :, :, 0, :])

    def step(state, inp):
        dec, ds = inp
        return dec[..., None] * state + ds, state

    init = jnp.zeros((B, H, dk, dv), jnp.float32)
    _, s_prev = lax.scan(step, init, (jnp.moveaxis(decay, 2, 0), jnp.moveaxis(d_state, 2, 0)))
    s_prev = jnp.moveaxis(s_prev, 0, 2)
    o = o_intra + jnp.einsum('bhncd,bhnde->bhnce', q_in, s_prev)
    return o.transpose(0, 2, 3, 1, 4).reshape(B, S, H, dv)


def nsa(q, kc, vc, ks, vs, kw, vw, gates, pe_k, pe_v, ck_w1, ck_w2, cv_w1, cv_w2):
    B, S, H, Dh = q.shape
    Hk = NSA_KV_HEADS
    G = H // Hk
    dt = q.dtype
    scale = Dh ** -0.5
    t_idx = jnp.arange(S)
    qg = q.reshape(B, S, Hk, G, Dh)

    nc = (S - CMP_BLOCK) // CMP_STRIDE + 1
    win_idx = jnp.arange(nc)[:, None] * CMP_STRIDE + jnp.arange(CMP_BLOCK)[None, :]

    def compress(t, pe, w1, w2):
        blk = t[:, win_idx] + pe[None, None, :, None, :]
        blk = blk.transpose(0, 1, 3, 2, 4).reshape(B, nc, Hk, CMP_BLOCK * Dh)
        return jax.nn.gelu(blk @ w1) @ w2

    k_cmp = compress(kc, pe_k, ck_w1, ck_w2)
    v_cmp = compress(vc, pe_v, cv_w1, cv_w2)
    cmp_start = jnp.arange(nc) * CMP_STRIDE
    cmp_valid = (cmp_start + CMP_BLOCK - 1)[None, :] <= t_idx[:, None]
    s_c = jnp.einsum('bskgd,bnkd->bkgsn', qg, k_cmp).astype(jnp.float32) * scale
    p_c = masked_softmax(s_c, cmp_valid) * jnp.any(cmp_valid, axis=-1)[:, None]
    o_cmp = jnp.einsum('bkgsn,bnkd->bskgd', p_c.astype(dt), v_cmp)

    nsb = S // SEL_BLOCK
    sel_start = jnp.arange(nsb) * SEL_BLOCK
    lo = jnp.maximum(cmp_start[:, None], sel_start[None, :])
    hi = jnp.minimum(cmp_start[:, None] + CMP_BLOCK, sel_start[None, :] + SEL_BLOCK)
    overlap = jnp.clip(hi - lo, 0).astype(jnp.float32) / CMP_BLOCK
    imp = jnp.einsum('bkgsn,nj->bksj', p_c, overlap)
    j = jnp.arange(nsb)[None, :]
    blk_t = (t_idx // SEL_BLOCK)[:, None]
    forced = (j == 0) | (j == blk_t) | (j == blk_t - 1)
    causal_blk = sel_start[None, :] <= t_idx[:, None]
    imp = jnp.where(forced, BIG, jnp.where(causal_blk, imp, NEG))
    n_top = min(SEL_TOPK, nsb)
    _, sel_idx = lax.top_k(imp, n_top)

    ks_b = ks.reshape(B, nsb, SEL_BLOCK, Hk, Dh).transpose(0, 3, 1, 2, 4)
    vs_b = vs.reshape(B, nsb, SEL_BLOCK, Hk, Dh).transpose(0, 3, 1, 2, 4)
    gather = jax.vmap(jax.vmap(lambda kb, ix: kb[ix]))
    nq = S // SEL_QBLK
    q_ch = qg.reshape(B, nq, SEL_QBLK, Hk, G, Dh).transpose(1, 0, 3, 4, 2, 5)
    idx_ch = sel_idx.reshape(B, Hk, nq, SEL_QBLK, n_top).transpose(2, 0, 1, 3, 4)
    t_ch = t_idx.reshape(nq, SEL_QBLK)
    offs = jnp.arange(SEL_BLOCK)

    def sel_step(args):
        qc, ic, tc = args
        kg = gather(ks_b, ic)
        vg = gather(vs_b, ic)
        s = jnp.einsum('bkgqd,bkqnld->bkgqnl', qc, kg).astype(jnp.float32) * scale
        kpos = ic[..., None] * SEL_BLOCK + offs
        mask = (kpos <= tc[None, None, :, None, None]).reshape(B, Hk, 1, SEL_QBLK, n_top * SEL_BLOCK)
        p = masked_softmax(s.reshape(B, Hk, G, SEL_QBLK, n_top * SEL_BLOCK), mask)
        return jnp.einsum('bkgqm,bkqmd->bkgqd', p.astype(dt),
                          vg.reshape(B, Hk, SEL_QBLK, n_top * SEL_BLOCK, Dh))

    o_sel = lax.map(sel_step, (q_ch, idx_ch, t_ch))
    o_sel = o_sel.transpose(1, 0, 4, 2, 3, 5).reshape(B, S, Hk, G, Dh)

    nw = S // WIN_QBLK
    span = WINDOW + WIN_QBLK
    kw_p = jnp.pad(kw, ((0, 0), (WINDOW, 0), (0, 0), (0, 0)))
    vw_p = jnp.pad(vw, ((0, 0), (WINDOW, 0), (0, 0), (0, 0)))
    q_wb = qg.reshape(B, nw, WIN_QBLK, Hk, G, Dh).transpose(1, 0, 3, 4, 2, 5)

    def win_step(args):
        qc, i = args
        start = i * WIN_QBLK
        kb = lax.dynamic_slice_in_dim(kw_p, start, span, axis=1)
        vb = lax.dynamic_slice_in_dim(vw_p, start, span, axis=1)
        s = jnp.einsum('bkgqd,bskd->bkgqs', qc, kb).astype(jnp.float32) * scale
        tq = start + jnp.arange(WIN_QBLK)
        sk = start - WINDOW + jnp.arange(span)
        mask = (sk[None, :] <= tq[:, None]) & (sk[None, :] > tq[:, None] - WINDOW) & (sk[None, :] >= 0)
        p = masked_softmax(s, mask)
        return jnp.einsum('bkgqs,bskd->bkgqd', p.astype(dt), vb)

    o_win = lax.map(win_step, (q_wb, jnp.arange(nw)))
    o_win = o_win.transpose(1, 0, 4, 2, 3, 5).reshape(B, S, Hk, G, Dh)

    g = gates.reshape(B, S, Hk, G, NSA_BRANCHES)
    o = g[..., 0:1] * o_cmp + g[..., 1:2] * o_sel + g[..., 2:3] * o_win
    return o.reshape(B, S, H * Dh)


def hybrid_mixer(h, pos, w_in, gla_w_a2, gla_b_a, gla_norm_g, pe_k, pe_v,
                 ck_w1, ck_w2, cv_w1, cv_w2, nsa_norm_g, w_o):
    B, S, _ = h.shape
    proj = h @ w_in
    cuts = [int(i) for i in np.cumsum(IN_SPLITS)[:-1]]
    (g_q, g_k, g_v, g_g, g_r, n_q, n_kc, n_vc, n_ks, n_vs, n_kw, n_vw, n_gate) = jnp.split(proj, cuts, axis=-1)

    log_a = jax.nn.log_sigmoid((g_r @ gla_w_a2 + gla_b_a).astype(jnp.float32)) / GLA_TAU
    o_gla = gla_chunked(g_q.reshape(B, S, GLA_HEADS, GLA_DK), g_k.reshape(B, S, GLA_HEADS, GLA_DK),
                        g_v.reshape(B, S, GLA_HEADS, GLA_DV),
                        log_a.reshape(B, S, GLA_HEADS, GLA_DK)).astype(h.dtype)
    o_gla = rms_norm(o_gla, gla_norm_g.reshape(GLA_HEADS, GLA_DV)).reshape(B, S, GLA_WIDTH) * jax.nn.silu(g_g)

    q = rope(n_q.reshape(B, S, NSA_HEADS, NSA_DH), pos)
    kvh = lambda t: t.reshape(B, S, NSA_KV_HEADS, NSA_DH)
    o_nsa = nsa(q, rope(kvh(n_kc), pos), kvh(n_vc), rope(kvh(n_ks), pos), kvh(n_vs),
                rope(kvh(n_kw), pos), kvh(n_vw), jax.nn.sigmoid(n_gate),
                pe_k, pe_v, ck_w1, ck_w2, cv_w1, cv_w2)
    o_nsa = rms_norm(o_nsa, nsa_norm_g)

    return jnp.concatenate([o_gla, o_nsa], axis=-1) @ w_o


def setup_inputs(seed: int = 0) -> dict:
    key = jax.random.key(seed)
    ks = jax.random.split(key, 24)
    L = DEPTH
    f32 = jnp.float32

    def nrm(k, shape, scale):
        return jax.random.normal(k, shape, f32) * scale

    offsets = jax.random.randint(ks[2], (BATCH, 1), 0, 4096, dtype=jnp.int32)
    positions = offsets + jnp.arange(SEQ, dtype=jnp.int32)[None, :]
    return {
        'x': nrm(ks[0], (BATCH, SEQ, D_MODEL), 1.0),
        'c': nrm(ks[1], (BATCH, D_MODEL), 1.0),
        'positions': positions,
        'w_ada': nrm(ks[3], (L, D_MODEL, N_MOD * D_MODEL), D_MODEL ** -0.5),
        'b_ada': nrm(ks[4], (L, N_MOD * D_MODEL), 0.01),
        'norm1_g': 1.0 + nrm(ks[5], (L, D_MODEL), 0.01),
        'w_in': nrm(ks[6], (L, D_MODEL, D_IN), D_MODEL ** -0.5),
        'gla_w_a2': nrm(ks[7], (L, GLA_RANK, GLA_HEADS * GLA_DK), GLA_RANK ** -0.5),
        'gla_b_a': nrm(ks[8], (L, GLA_HEADS * GLA_DK), 0.01),
        'gla_norm_g': 1.0 + nrm(ks[9], (L, GLA_WIDTH), 0.01),
        'nsa_pe_k': nrm(ks[10], (L, CMP_BLOCK, NSA_DH), 0.02),
        'nsa_pe_v': nrm(ks[11], (L, CMP_BLOCK, NSA_DH), 0.02),
        'cmp_k_w1': nrm(ks[12], (L, CMP_BLOCK * NSA_DH, CMP_HIDDEN), (CMP_BLOCK * NSA_DH) ** -0.5),
        'cmp_k_w2': nrm(ks[13], (L, CMP_HIDDEN, NSA_DH), CMP_HIDDEN ** -0.5),
        'cmp_v_w1': nrm(ks[14], (L, CMP_BLOCK * NSA_DH, CMP_HIDDEN), (CMP_BLOCK * NSA_DH) ** -0.5),
        'cmp_v_w2': nrm(ks[15], (L, CMP_HIDDEN, NSA_DH), CMP_HIDDEN ** -0.5),
        'nsa_norm_g': 1.0 + nrm(ks[16], (L, NSA_WIDTH), 0.01),
        'w_o': nrm(ks[17], (L, GLA_WIDTH + NSA_WIDTH, D_MODEL), (GLA_WIDTH + NSA_WIDTH) ** -0.5),
        'norm2_g': 1.0 + nrm(ks[18], (L, D_MODEL), 0.01),
        'w_ff1': nrm(ks[19], (L, D_MODEL, D_FF), D_MODEL ** -0.5),
        'w_ff2': nrm(ks[20], (L, D_FF, D_MODEL), D_FF ** -0.5),
        'final_norm_g': 1.0 + nrm(ks[21], (D_MODEL,), 0.01),
    }


def reference(x, c, positions, w_ada, b_ada, norm1_g, w_in, gla_w_a2, gla_b_a, gla_norm_g,
              nsa_pe_k, nsa_pe_v, cmp_k_w1, cmp_k_w2, cmp_v_w1, cmp_v_w2, nsa_norm_g, w_o,
              norm2_g, w_ff1, w_ff2, final_norm_g):
    for l in range(DEPTH):
        mod = (jax.nn.silu(c) @ w_ada[l] + b_ada[l])[:, None, :]
        sh1, sc1, ga1, sh2, sc2, ga2 = jnp.split(mod, N_MOD, axis=-1)
        h = rms_norm(x, norm1_g[l]) * (1 + sc1) + sh1
        x = x + ga1 * hybrid_mixer(h, positions, w_in[l], gla_w_a2[l], gla_b_a[l], gla_norm_g[l],
                                   nsa_pe_k[l], nsa_pe_v[l], cmp_k_w1[l], cmp_k_w2[l],
                                   cmp_v_w1[l], cmp_v_w2[l], nsa_norm_g[l], w_o[l])
        h = rms_norm(x, norm2_g[l]) * (1 + sc2) + sh2
        x = x + ga2 * (jnp.square(jax.nn.relu(h @ w_ff1[l])) @ w_ff2[l])
    return rms_norm(x, final_norm_g)
```

```cpp
#include <hip/hip_runtime.h>
#include <cstdio>
#include <cstdint>
#include <cmath>

constexpr int BATCH = 16, SEQ = 2048, DM = 1024, MTOK = BATCH * SEQ, DFF = 4096, DIN = 3612, NPROJ = 3840, NMOD = 6 * DM;
constexpr float RMS_EPS = 1e-6f;

namespace pg8 {
#define PG8_LAS __attribute__((address_space(3)))
typedef unsigned short bf16_t;
typedef short bf16x8 __attribute__((ext_vector_type(8)));
typedef float f32x4 __attribute__((ext_vector_type(4)));
typedef unsigned u32x4 __attribute__((ext_vector_type(4)));
constexpr int BM = 256, BK = 64, HALF = 128, HTB = HALF * BK * 2  , STAGE_BYTES = 8 * HTB, NXCD = 8, WGM = 8;

__host__ __device__ __forceinline__ int lds_byte(int r, int c) { const int st = (r >> 4) * 2 + (c >> 5), rr = r & 15, cc = c & 31, ob = rr * 64 + cc * 2; return st * 1024 + (ob ^ (((ob >> 9) & 1) << 5)); }
__host__ __device__ __forceinline__ void stage_rc(int b, int& R, int& C) { const int st = b / 1024, sb = b % 1024, swz = sb ^ (((sb >> 9) & 1) << 5); R = (st >> 1) * 16 + swz / 64; C = (st & 1) * 32 + (swz % 64) / 2; }
__host__ __device__ __forceinline__ int perm32(int rho) { const int n = rho >> 4, i = rho & 15; return 8 * (i >> 2) + 4 * n + (i & 3); }

struct Unit { int pm, pn; };
struct Gemm { const bf16_t* A; const bf16_t* Bt; int M, N, K, lda; };

struct StaticOrder {
    int nM, nN, nwg, G, c;
    __host__ __device__ void init(int M, int N, int G_, int c_) { nM = M / BM; nN = N / BM; nwg = nM * nN; G = G_; c = c_; }
    __host__ __device__ bool next(int i, Unit& u) const {
        const long L = (long)i * G + c; if (L >= nwg) return false;
        int wgid = (int)L; { const int q = nwg / NXCD, r = nwg % NXCD, xcd = wgid % NXCD, off = wgid / NXCD; wgid = (xcd < r ? xcd * (q + 1) : r * (q + 1) + (xcd - r) * q) + off; }
        const int nig = WGM * nN, gid = wgid / nig, fm = gid * WGM, gsz = (nM - fm) < WGM ? (nM - fm) : WGM;
        u.pm = fm + ((wgid % nig) % gsz); u.pn = (wgid % nig) / gsz; return true;
    }
    __device__ __forceinline__ void a_ready(const Unit&) const {}
    __device__ __forceinline__ void done(const Unit&) const {}
};

__device__ __forceinline__ unsigned cvt_pk_bf16(float lo, float hi) { unsigned r; asm volatile("v_cvt_pk_bf16_f32 %0, %1, %2" : "=v"(r) : "v"(lo), "v"(hi)); return r; }
typedef unsigned u32x2 __attribute__((ext_vector_type(2)));
struct OneUnit { int pm, pn;
    __device__ __forceinline__ bool next(int i, Unit& u) const { if (i) return false; u.pm = pm; u.pn = pn; return true; }
    __device__ __forceinline__ void a_ready(const Unit&) const {}
    __device__ __forceinline__ void done(const Unit&) const {} };

struct EpiInProj {
    static constexpr bool PERM = true, AFTER_DRAIN = false;
    bf16_t* gla; bf16_t* nq; bf16_t* kv; size_t kv_stride; float* rg; const float* tab;
    __device__ __forceinline__ void operator()(const f32x4 (&acc)[2][2][4][2], const Unit& u, int wr, int wc, int fr, int fq) const {
        const int pn = u.pn, row0 = u.pm * BM + wr * 64 + fr, c8 = wc * 32 + 8 * fq;
        if (pn < 6) {
#pragma unroll
            for (int ai = 0; ai < 2; ++ai)
#pragma unroll
                for (int m = 0; m < 4; ++m) { bf16_t* rowp = gla + (size_t)(row0 + ai * HALF + m * 16) * 1536 + pn * 256 + c8;
#pragma unroll
                    for (int bj = 0; bj < 2; ++bj) { const f32x4 v0 = acc[ai][bj][m][0], v1 = acc[ai][bj][m][1];
                        u32x4 w; w.x = cvt_pk_bf16(v0[0], v0[1]); w.y = cvt_pk_bf16(v0[2], v0[3]); w.z = cvt_pk_bf16(v1[0], v1[1]); w.w = cvt_pk_bf16(v1[2], v1[3]);
                        *(u32x4*)(rowp + bj * HALF) = w; } }
        } else if (pn == 14) {
            if (wc == 0) {
#pragma unroll
                for (int ai = 0; ai < 2; ++ai)
#pragma unroll
                    for (int m = 0; m < 4; ++m) { float* rp = rg + (size_t)(row0 + ai * HALF + m * 16) * 32 + 8 * fq;
                        *(f32x4*)rp = acc[ai][0][m][0]; *(f32x4*)(rp + 4) = acc[ai][0][m][1]; }
            }
        } else {
            const int b = (u.pm * BM) / SEQ, s0 = (u.pm * BM) % SEQ + wr * 64 + fr;
            bf16_t* T; int NH, hbase; bool rope;
            if (pn <= 7) { T = nq; NH = 4; hbase = 2 * (pn - 6); rope = true; }
            else { const int t = pn - 8; T = kv + (size_t)t * kv_stride; NH = 2; hbase = 0; rope = (t & 1) == 0; }
#pragma unroll
            for (int bj = 0; bj < 2; ++bj) { bf16_t* hb = T + (size_t)(b * NH + hbase + bj) * SEQ * 128;
#pragma unroll
                for (int ai = 0; ai < 2; ++ai)
#pragma unroll
                    for (int m = 0; m < 4; ++m) { const int s = s0 + ai * HALF + m * 16; const f32x4 v0 = acc[ai][bj][m][0], v1 = acc[ai][bj][m][1];
                        if (rope) { const int d0 = 16 * wc + 4 * fq; const f32x4* tp = (const f32x4*)(tab + ((size_t)(row0 + ai * HALF + m * 16) * 64 + d0) * 2);
                            const f32x4 ca = tp[0], cb = tp[1];
                            u32x2 w1, w2;
                            w1.x = cvt_pk_bf16(v0[0] * ca[0] - v1[0] * ca[1], v0[1] * ca[2] - v1[1] * ca[3]);
                            w1.y = cvt_pk_bf16(v0[2] * cb[0] - v1[2] * cb[1], v0[3] * cb[2] - v1[3] * cb[3]);
                            w2.x = cvt_pk_bf16(v1[0] * ca[0] + v0[0] * ca[1], v1[1] * ca[2] + v0[1] * ca[3]);
                            w2.y = cvt_pk_bf16(v1[2] * cb[0] + v0[2] * cb[1], v1[3] * cb[2] + v0[3] * cb[3]);
                            *(u32x2*)(hb + (size_t)s * 128 + d0) = w1; *(u32x2*)(hb + (size_t)s * 128 + 64 + d0) = w2;
                        } else { u32x4 w; w.x = cvt_pk_bf16(v0[0], v0[1]); w.y = cvt_pk_bf16(v0[2], v0[3]); w.z = cvt_pk_bf16(v1[0], v1[1]); w.w = cvt_pk_bf16(v1[2], v1[3]);
                            *(u32x4*)(hb + (size_t)s * 128 + c8) = w; } } }
        }
    }
};
template <int ACT> struct EpiActBf16 {
    static constexpr bool PERM = true, AFTER_DRAIN = false;
    bf16_t* O; int ldc; const float* bias;
    __device__ __forceinline__ float act(float x) const {
        if (ACT == 1) { const float u2 = 1.5957691216f * (x + 0.044715f * x * x * x); return x / (1.0f + __expf(-u2)); }
        else { const float r = fmaxf(x, 0.f); return r * r; } }
    __device__ __forceinline__ void operator()(const f32x4 (&acc)[2][2][4][2], const Unit& u, int wr, int wc, int fr, int fq) const {
        const int row0 = u.pm * BM + wr * 64 + fr, col0 = u.pn * BM + wc * 32 + 8 * fq;
        f32x4 bv[2][2];
#pragma unroll
        for (int bj = 0; bj < 2; ++bj)
#pragma unroll
            for (int n = 0; n < 2; ++n) bv[bj][n] = bias ? *(const f32x4*)(bias + col0 + bj * HALF + 4 * n) : (f32x4){0.f, 0.f, 0.f, 0.f};
#pragma unroll
        for (int ai = 0; ai < 2; ++ai)
#pragma unroll
            for (int m = 0; m < 4; ++m) { bf16_t* rowp = O + (size_t)(row0 + ai * HALF + m * 16) * ldc + col0;
#pragma unroll
                for (int bj = 0; bj < 2; ++bj) { const f32x4 v0 = acc[ai][bj][m][0] + bv[bj][0], v1 = acc[ai][bj][m][1] + bv[bj][1];
                    u32x4 w; w.x = cvt_pk_bf16(act(v0[0]), act(v0[1])); w.y = cvt_pk_bf16(act(v0[2]), act(v0[3])); w.z = cvt_pk_bf16(act(v1[0]), act(v1[1])); w.w = cvt_pk_bf16(act(v1[2]), act(v1[3]));
                    *(u32x4*)(rowp + bj * HALF) = w; } }
    }
};
struct EpiResid {
    static constexpr bool PERM = false, AFTER_DRAIN = false;
    const float* base; float* out; const float* gate;
    __device__ __forceinline__ void operator()(const f32x4 (&acc)[2][2][4][2], const Unit& u, int wr, int wc, int fr, int fq) const {
        const int row0 = u.pm * BM + wr * 64 + fr, col0 = u.pn * BM + wc * 32 + 4 * fq; const int b = (u.pm * BM) / SEQ;
        f32x4 gv[2][2];
#pragma unroll
        for (int bj = 0; bj < 2; ++bj)
#pragma unroll
            for (int n = 0; n < 2; ++n) gv[bj][n] = *(const f32x4*)(gate + (size_t)b * NMOD + col0 + bj * HALF + n * 16);
#pragma unroll
        for (int ai = 0; ai < 2; ++ai)
#pragma unroll
            for (int m = 0; m < 4; ++m) { const size_t off = (size_t)(row0 + ai * HALF + m * 16) * DM + col0;
#pragma unroll
                for (int bj = 0; bj < 2; ++bj)
#pragma unroll
                    for (int n = 0; n < 2; ++n) { const f32x4 bs = *(const f32x4*)(base + off + bj * HALF + n * 16);
                        *(f32x4*)(out + off + bj * HALF + n * 16) = bs + gv[bj][n] * acc[ai][bj][m][n]; } }
    }
};
template <class Epi, class Sched, bool ALIGN_EPI = false, bool SP2 = false>
__device__ __forceinline__ void gemm_phase(PG8_LAS unsigned char* lds, const Gemm g, const Sched& S, const Epi& E) {
    const int tid = threadIdx.x, wid = __builtin_amdgcn_readfirstlane(tid >> 6), lane = tid & 63, wr = wid >> 2, wc = wid & 3, fr = lane & 15, fq = lane >> 4;
    const int K = g.K, nt = K / BK;
    unsigned voffA[2], voffB[2];
#pragma unroll
    for (int i = 0; i < 2; ++i) { int R, C; stage_rc(tid * 16 + i * 8192, R, C); const int Rb = Epi::PERM ? ((R & ~31) + perm32(R & 31)) : R;
        voffA[i] = (unsigned)(R * g.lda + C) * 2u; voffB[i] = (unsigned)(Rb * K + C) * 2u; }
    const size_t kstep = (size_t)(BK * 2);
    const size_t hstepB = (size_t)HALF * K * 2, hstepA = (size_t)HALF * g.lda * 2;
    const size_t tstepB = 2 * hstepB, tstepA = 2 * hstepA;
    const unsigned ldsw = (unsigned)wid * 1024u;
    const int aoff = lds_byte(wr * 64 + fr, fq * 8), boff = lds_byte(wc * 32 + fr, fq * 8);
#define PG8_SA(b, h) (((b) * 2 + (h)) * HTB)
#define PG8_SB(b, h) ((4 + (b) * 2 + (h)) * HTB)
#define PG8_STAGE(bufoff, gbase, voff) do { _Pragma("unroll") for (int _i = 0; _i < 2; ++_i) \
        __builtin_amdgcn_global_load_lds((const unsigned*)((const char*)(gbase) + (voff)[_i]), (PG8_LAS unsigned*)(lds + (bufoff) + ldsw + _i * 8192), 16, 0, 0); } while (0)
#define PG8_LDA(dst, b, h) do { _Pragma("unroll") for (int m = 0; m < 4; ++m) _Pragma("unroll") for (int k = 0; k < 2; ++k) dst[m][k] = *(const PG8_LAS bf16x8*)(lds + PG8_SA(b, h) + aoff + m * 2048 + k * 1024); } while (0)
#define PG8_LDB(dst, b, h) do { _Pragma("unroll") for (int n = 0; n < 2; ++n) _Pragma("unroll") for (int k = 0; k < 2; ++k) dst[n][k] = *(const PG8_LAS bf16x8*)(lds + PG8_SB(b, h) + boff + n * 2048 + k * 1024); } while (0)
#define PG8_MMA(ai, bj, At, Bt) do { __builtin_amdgcn_s_setprio(1); _Pragma("unroll") for (int m = 0; m < 4; ++m) _Pragma("unroll") for (int n = 0; n < 2; ++n) _Pragma("unroll") for (int k = 0; k < 2; ++k) \
        acc[ai][bj][m][n] = __builtin_amdgcn_mfma_f32_16x16x32_bf16(Bt[n][k], At[m][k], acc[ai][bj][m][n], 0, 0, 0); __builtin_amdgcn_s_setprio(0); } while (0)
#define PG8_WAIT_V(n) asm volatile("s_waitcnt vmcnt(" #n ")" ::: "memory")
#define PG8_WAIT_L(n) asm volatile("s_waitcnt lgkmcnt(" #n ")" ::: "memory")
#define PG8_BAR __builtin_amdgcn_s_barrier()
#define PG8_SCHED __builtin_amdgcn_sched_barrier(0)
    Unit cur, nxt; int ui = 0;
    if (!S.next(0, cur)) return;
    f32x4 acc[2][2][4][2];
#pragma unroll
    for (int a = 0; a < 2; ++a)
#pragma unroll
        for (int b = 0; b < 2; ++b)
#pragma unroll
            for (int m = 0; m < 4; ++m)
#pragma unroll
                for (int n = 0; n < 2; ++n) acc[a][b][m][n] = (f32x4){0.f, 0.f, 0.f, 0.f};
    bf16x8 At[4][2], B0[2][2], B1[2][2];
    const char* cA = (const char*)g.A + (size_t)cur.pm * tstepA; const char* cB = (const char*)g.Bt + (size_t)cur.pn * tstepB;
    S.a_ready(cur);
    if constexpr (SP2) {
        PG8_STAGE(PG8_SB(0, 0), cB, voffB); PG8_STAGE(PG8_SB(0, 1), cB + hstepB, voffB); PG8_STAGE(PG8_SA(0, 0), cA, voffA); PG8_STAGE(PG8_SA(0, 1), cA + hstepA, voffA);
        if (wr == 1) PG8_BAR;
        PG8_WAIT_V(2); PG8_BAR;
        PG8_STAGE(PG8_SB(1, 0), cB + kstep, voffB); PG8_STAGE(PG8_SA(1, 0), cA + kstep, voffA); PG8_STAGE(PG8_SB(1, 1), cB + hstepB + kstep, voffB);
        PG8_WAIT_V(6); PG8_BAR;
    } else {
        PG8_STAGE(PG8_SB(0, 0), cB, voffB); PG8_STAGE(PG8_SA(0, 0), cA, voffA); PG8_STAGE(PG8_SB(0, 1), cB + hstepB, voffB); PG8_STAGE(PG8_SA(0, 1), cA + hstepA, voffA);
        if (wr == 1) PG8_BAR;
        PG8_WAIT_V(4); PG8_BAR;
        PG8_STAGE(PG8_SB(1, 0), cB + kstep, voffB); PG8_STAGE(PG8_SA(1, 0), cA + kstep, voffA); PG8_STAGE(PG8_SB(1, 1), cB + hstepB + kstep, voffB);
        PG8_WAIT_V(6); PG8_BAR;
    }
    for (;;) {
        const bool has_next = S.next(ui + 1, nxt);
        const char* nA = has_next ? (const char*)g.A + (size_t)nxt.pm * tstepA : cA; const char* nB = has_next ? (const char*)g.Bt + (size_t)nxt.pn * tstepB : cB;
        for (int t = 0; t < nt; t += 2) {
            const bool last = (t == nt - 2);
            const char* a1 = cA + (size_t)(t + 1) * kstep;
            const char* a2 = last ? nA : cA + (size_t)(t + 2) * kstep; const char* b2 = last ? nB : cB + (size_t)(t + 2) * kstep;
            const char* a3 = a2 + kstep; const char* b3 = b2 + kstep;
            if (last && has_next) S.a_ready(nxt);
            if constexpr (SP2) {
            PG8_LDB(B0, 0, 0); PG8_LDB(B1, 0, 1); PG8_SCHED; PG8_LDA(At, 0, 0); PG8_STAGE(PG8_SA(1, 1), a1 + hstepA, voffA);
            PG8_WAIT_V(8); PG8_WAIT_L(0); PG8_BAR; PG8_MMA(0, 0, At, B0); PG8_MMA(0, 1, At, B1); PG8_BAR; PG8_SCHED;
            PG8_LDA(At, 0, 1); PG8_STAGE(PG8_SB(0, 0), b2, voffB); PG8_STAGE(PG8_SB(0, 1), b2 + hstepB, voffB); PG8_STAGE(PG8_SA(0, 0), a2, voffA);
            PG8_WAIT_V(8); PG8_WAIT_L(0); PG8_BAR; PG8_MMA(1, 0, At, B0); PG8_MMA(1, 1, At, B1); PG8_BAR; PG8_SCHED;
            PG8_LDB(B0, 1, 0); PG8_LDB(B1, 1, 1); PG8_SCHED; PG8_LDA(At, 1, 0); PG8_STAGE(PG8_SA(0, 1), a2 + hstepA, voffA);
            PG8_WAIT_V(8); PG8_WAIT_L(0); PG8_BAR; PG8_MMA(0, 0, At, B0); PG8_MMA(0, 1, At, B1); PG8_BAR; PG8_SCHED;
            PG8_LDA(At, 1, 1); PG8_STAGE(PG8_SB(1, 0), b3, voffB); PG8_STAGE(PG8_SB(1, 1), b3 + hstepB, voffB); PG8_STAGE(PG8_SA(1, 0), a3, voffA);
            PG8_WAIT_V(8); PG8_WAIT_L(0); PG8_BAR; PG8_MMA(1, 0, At, B0); PG8_MMA(1, 1, At, B1); PG8_BAR; PG8_SCHED;
            } else {
            PG8_LDB(B0, 0, 0); PG8_SCHED; PG8_LDA(At, 0, 0); PG8_STAGE(PG8_SA(1, 1), a1 + hstepA, voffA);
            PG8_WAIT_L(8); PG8_BAR; PG8_WAIT_L(0); PG8_MMA(0, 0, At, B0); PG8_BAR; PG8_SCHED;
            PG8_LDB(B1, 0, 1); PG8_STAGE(PG8_SB(0, 0), b2, voffB);
            PG8_BAR; PG8_WAIT_L(0); PG8_MMA(0, 1, At, B1); PG8_BAR;
            PG8_LDA(At, 0, 1); PG8_STAGE(PG8_SA(0, 0), a2, voffA);
            PG8_BAR; PG8_WAIT_L(0); PG8_MMA(1, 0, At, B0); PG8_BAR; PG8_SCHED;
            PG8_STAGE(PG8_SB(0, 1), b2 + hstepB, voffB);
            PG8_WAIT_V(6); PG8_BAR; PG8_MMA(1, 1, At, B1); PG8_BAR;
            PG8_LDB(B0, 1, 0); PG8_SCHED; PG8_LDA(At, 1, 0); PG8_STAGE(PG8_SA(0, 1), a2 + hstepA, voffA);
            PG8_WAIT_L(8); PG8_BAR; PG8_WAIT_L(0); PG8_MMA(0, 0, At, B0); PG8_BAR; PG8_SCHED;
            PG8_LDB(B1, 1, 1); PG8_STAGE(PG8_SB(1, 0), b3, voffB);
            PG8_BAR; PG8_WAIT_L(0); PG8_MMA(0, 1, At, B1); PG8_BAR;
            PG8_LDA(At, 1, 1); PG8_STAGE(PG8_SA(1, 0), a3, voffA);
            PG8_BAR; PG8_WAIT_L(0); PG8_MMA(1, 0, At, B0); PG8_BAR; PG8_SCHED;
            PG8_STAGE(PG8_SB(1, 1), b3 + hstepB, voffB);
            PG8_WAIT_V(6); PG8_BAR; PG8_MMA(1, 1, At, B1); PG8_BAR;
            }
        }
        if constexpr (ALIGN_EPI) { if (wr == 0) PG8_BAR; }
        if constexpr (!Epi::AFTER_DRAIN) { E(acc, cur, wr, wc, fr, fq); S.done(cur); }
        if (!has_next) break;
#pragma unroll
        for (int a = 0; a < 2; ++a)
#pragma unroll
            for (int b = 0; b < 2; ++b)
#pragma unroll
                for (int m = 0; m < 4; ++m)
#pragma unroll
                    for (int n = 0; n < 2; ++n) acc[a][b][m][n] = (f32x4){0.f, 0.f, 0.f, 0.f};
        cur = nxt; cA = nA; cB = nB; ++ui;
        if constexpr (ALIGN_EPI) { if (wr == 1) PG8_BAR; }
    }
    PG8_WAIT_V(0);
    if constexpr (!ALIGN_EPI) { if (wr == 0) PG8_BAR; }
    PG8_BAR;
    if constexpr (Epi::AFTER_DRAIN) { E.fused(acc, cur, wr, wc, fr, fq, lds, wid, lane); S.done(cur); }
#undef PG8_SA
#undef PG8_SB
#undef PG8_STAGE
#undef PG8_LDA
#undef PG8_LDB
#undef PG8_MMA
#undef PG8_WAIT_V
#undef PG8_WAIT_L
#undef PG8_BAR
#undef PG8_SCHED
}
}
namespace nsa {
typedef unsigned short bf16_t;
typedef short bf16x8 __attribute__((ext_vector_type(8)));
typedef short s16x4 __attribute__((ext_vector_type(4)));
typedef float f32x16 __attribute__((ext_vector_type(16)));
typedef float f32x4 __attribute__((ext_vector_type(4)));
typedef unsigned u32x4 __attribute__((ext_vector_type(4)));
constexpr int D = 128, KVBLK = 64, QBLK = 32, UROWS = 128;
constexpr float SCALE = 0.08838834764831845f;
constexpr int SHM_V = KVBLK * D * 2, SHM_K = KVBLK * D * 2;
constexpr int L_V = 0, L_K = 2 * SHM_V, L_WS = 2 * SHM_V + 2 * SHM_K, L_IMP = L_WS + 8 * 64 * 4, L_QF = L_IMP  , L_SELB = L_IMP + 2 * UROWS * 32 * 4, L_END = L_SELB + UROWS * 4;
#define KSWZ(row, colB) ((row) * 256 + ((colB) ^ (((row) & 7) << 4)))
#define SBAR() __builtin_amdgcn_sched_barrier(0)
__device__ __forceinline__ int v_st(int k, int c) { const int kk = (k & ~0xC) | ((k & 4) << 1) | ((k & 8) >> 1); return ((kk >> 3) * 4 + (c >> 5)) * 512 + ((kk & 7) * 32 + (c & 31)) * 2; }
__device__ __forceinline__ int v_rd_base(int lane) { return ((lane & 3) << 3) | (((lane >> 2) & 3) << 6) | (((lane >> 4) & 1) << 5) | (((lane >> 5) & 1) << 8); }
constexpr int v_rd_off(int d0, int ks, int half) { return d0 * 512 + ks * 4096 + half * 2048; }
__device__ __forceinline__ int crow(int r, int hi) { return (r & 3) + 8 * (r >> 2) + 4 * hi; }
__device__ __forceinline__ unsigned cvtpk(float lo, float hi) { unsigned r; asm volatile("v_cvt_pk_bf16_f32 %0, %1, %2" : "=v"(r) : "v"(lo), "v"(hi)); return r; }
__device__ __forceinline__ void mask_tile(f32x16& p0, f32x16& p1, int dq, unsigned W) {
    const float NEG = -__builtin_inff();
#pragma unroll
    for (int r = 0; r < 16; ++r) { const int c = (r & 3) + 8 * (r >> 2);
        if ((unsigned)(dq - c) >= W) p0[r] = NEG;
        if ((unsigned)(dq - c - 32) >= W) p1[r] = NEG; }
}
__device__ __forceinline__ void partialSM(f32x16& p0, f32x16& p1, float& m_reg, float& mn, float& alpha) {
    float pmax = p0[0];
#pragma unroll
    for (int r = 1; r < 16; ++r) pmax = fmaxf(pmax, p0[r]);
#pragma unroll
    for (int r = 0; r < 16; ++r) pmax = fmaxf(pmax, p1[r]);
    { auto rr = __builtin_amdgcn_permlane32_swap(__float_as_uint(pmax), __float_as_uint(pmax), false, false);
      pmax = fmaxf(__uint_as_float(rr[0]), __uint_as_float(rr[1])); }
    constexpr float C2 = 1.4426950408889634f * SCALE;
    if (__builtin_expect(__all(pmax <= m_reg), 0)) { mn = m_reg; alpha = 1.f; }
    else { mn = fmaxf(m_reg, pmax); alpha = __builtin_amdgcn_exp2f((m_reg - mn) * C2); m_reg = mn; }
    const float mnL = -mn * C2;
#pragma unroll
    for (int r = 0; r < 16; ++r) p0[r] = fmaf(p0[r], C2, mnL);
#pragma unroll
    for (int r = 0; r < 16; ++r) p1[r] = fmaf(p1[r], C2, mnL);
#pragma unroll
    for (int r = 0; r < 16; ++r) p0[r] = __builtin_amdgcn_exp2f(p0[r]);
}
#define PK4(P, B_, OUT) do { unsigned a0 = cvtpk(P[B_+0], P[B_+1]), a1 = cvtpk(P[B_+2], P[B_+3]);                          \
        unsigned b0 = cvtpk(P[B_+4], P[B_+5]), b1 = cvtpk(P[B_+6], P[B_+7]);                                             \
        auto r0 = __builtin_amdgcn_permlane32_swap(a0, b0, false, false); auto r1 = __builtin_amdgcn_permlane32_swap(a1, b1, false, false); \
        u32x4 w = {r0[0], r1[0], r0[1], r1[1]}; OUT = *reinterpret_cast<bf16x8*>(&w); } while (0)
__device__ __forceinline__ void finishSM(f32x16& p0, f32x16& p1, float alpha, float& l_reg, bf16x8& pa0, bf16x8& pa1, bf16x8& pa2, bf16x8& pa3) {
#pragma unroll
    for (int r = 0; r < 16; ++r) p1[r] = __builtin_amdgcn_exp2f(p1[r]);
    float ps = 0;
#pragma unroll
    for (int r = 0; r < 16; ++r) ps += p0[r];
#pragma unroll
    for (int r = 0; r < 16; ++r) ps += p1[r];
    { auto rr = __builtin_amdgcn_permlane32_swap(__float_as_uint(ps), __float_as_uint(ps), false, false);
      ps = __uint_as_float(rr[0]) + __uint_as_float(rr[1]); }
    l_reg = l_reg * alpha + ps;
    PK4(p0, 0, pa0); PK4(p0, 8, pa1); PK4(p1, 0, pa2); PK4(p1, 8, pa3);
}
template <int KB>
__device__ __forceinline__ void qkt(f32x16& p0, f32x16& p1, const char* K_lds, int r32, int hi, const bf16x8* qr) {
    p0 = f32x16{}; p1 = f32x16{};
    const char* kb[4];
#pragma unroll
    for (int dd = 0; dd < 4; ++dd) kb[dd] = K_lds + KB * SHM_K + KSWZ(r32, (dd * 16 + hi * 8) * 2);
#pragma unroll
    for (int d0 = 0; d0 < 8; ++d0) { const char* a = kb[d0 & 3] + (d0 >> 2) * 128;
        bf16x8 b0 = *reinterpret_cast<const bf16x8*>(a);
        bf16x8 b1 = *reinterpret_cast<const bf16x8*>(a + 32 * 256);
        p0 = __builtin_amdgcn_mfma_f32_32x32x16_bf16(b0, qr[d0], p0, 0, 0, 0);
        p1 = __builtin_amdgcn_mfma_f32_32x32x16_bf16(b1, qr[d0], p1, 0, 0, 0); }
}
template <int KB>
__device__ __forceinline__ void qkt2(f32x16& p0, f32x16& p1, const char* K_lds, int r32, int hi, const bf16x8* qr, const char* qf) {
    p0 = f32x16{}; p1 = f32x16{};
    const char* kb[4];
#pragma unroll
    for (int dd = 0; dd < 4; ++dd) kb[dd] = K_lds + KB * SHM_K + KSWZ(r32, (dd * 16 + hi * 8) * 2);
#pragma unroll
    for (int d0 = 0; d0 < 8; ++d0) { const char* a = kb[d0 & 3] + (d0 >> 2) * 128;
        bf16x8 b0 = *reinterpret_cast<const bf16x8*>(a);
        bf16x8 b1 = *reinterpret_cast<const bf16x8*>(a + 32 * 256);
        const bf16x8 q = d0 < 4 ? qr[d0] : *reinterpret_cast<const bf16x8*>(qf + (d0 - 4) * 1024);
        p0 = __builtin_amdgcn_mfma_f32_32x32x16_bf16(b0, q, p0, 0, 0, 0);
        p1 = __builtin_amdgcn_mfma_f32_32x32x16_bf16(b1, q, p1, 0, 0, 0); }
}
template <int VB>
__device__ __forceinline__ void pv_tile(f32x16* o, int vb0, bf16x8 pa0, bf16x8 pa1, bf16x8 pa2, bf16x8 pa3) {
#define TRRD(dst, off) asm volatile("ds_read_b64_tr_b16 %0, %1 offset:%2" : "=&v"(dst) : "v"(vb0), "i"(off) : "memory")
#define PV_D0(d0) do { s16x4 l0, l1, l2, l3, h0, h1, h2, h3; constexpr int b_ = VB * SHM_V + v_rd_off(d0, 0, 0); \
        TRRD(l0, b_); TRRD(h0, b_ + 2048); TRRD(l1, b_ + 4096); TRRD(h1, b_ + 6144); TRRD(l2, b_ + 8192); TRRD(h2, b_ + 10240); TRRD(l3, b_ + 12288); TRRD(h3, b_ + 14336); \
        asm volatile("s_waitcnt lgkmcnt(0)" ::: "memory"); SBAR();   \
        o[d0] = __builtin_amdgcn_mfma_f32_32x32x16_bf16(pa0, (bf16x8){l0[0], l0[1], l0[2], l0[3], h0[0], h0[1], h0[2], h0[3]}, o[d0], 0, 0, 0);   \
        o[d0] = __builtin_amdgcn_mfma_f32_32x32x16_bf16(pa1, (bf16x8){l1[0], l1[1], l1[2], l1[3], h1[0], h1[1], h1[2], h1[3]}, o[d0], 0, 0, 0);   \
        o[d0] = __builtin_amdgcn_mfma_f32_32x32x16_bf16(pa2, (bf16x8){l2[0], l2[1], l2[2], l2[3], h2[0], h2[1], h2[2], h2[3]}, o[d0], 0, 0, 0);   \
        o[d0] = __builtin_amdgcn_mfma_f32_32x32x16_bf16(pa3, (bf16x8){l3[0], l3[1], l3[2], l3[3], h3[0], h3[1], h3[2], h3[3]}, o[d0], 0, 0, 0); } while (0)
    PV_D0(0); PV_D0(1); PV_D0(2); PV_D0(3);
#undef PV_D0
#undef TRRD
}
__device__ __forceinline__ int swa_jlo(int P0, int W) { const int lowk = P0 - W + 1; return lowk > 0 ? lowk / KVBLK : 0; }
#define ROW(p, k0, rr) ((p) + (size_t)((k0) + (rr)) * D + sc)
#define VMW() asm volatile("s_waitcnt vmcnt(0)" ::: "memory")
#define SLOAD_H(Kp, Vp, k0) do { st_v0 = *(const bf16x8*)ROW(Vp, k0, sr); st_v1 = *(const bf16x8*)ROW(Vp, k0, 32 + sr); \
                                 st_k0 = *(const bf16x8*)ROW(Kp, k0, sr); st_k1 = *(const bf16x8*)ROW(Kp, k0, 32 + sr); } while (0)
#define SWRITE_HK(bf) do { *(bf16x8*)(K_lds + (bf) * SHM_K + kws) = st_k0; *(bf16x8*)(K_lds + (bf) * SHM_K + kws + 32 * 256) = st_k1; } while (0)
#define SWRITE_HV(bf) do { *(bf16x8*)(V_lds + (bf) * SHM_V + vst0) = st_v0; *(bf16x8*)(V_lds + (bf) * SHM_V + vst1) = st_v1; } while (0)
#define SWRITE_H(bf) do { SWRITE_HV(bf); SWRITE_HK(bf); } while (0)
#define STORE_O() do { if (hi == 0) li_l[r32] = l_inv; asm volatile("s_waitcnt lgkmcnt(0)" ::: "memory"); float rli[16];                       \
        __attribute__((address_space(1))) bf16_t* Ob_ = (__attribute__((address_space(1))) bf16_t*)Ow; asm volatile("" : "+v"(Ob_));           \
        _Pragma("unroll") for (int r = 0; r < 16; ++r) rli[r] = li_l[crow(r, hi)];                                                         \
        _Pragma("unroll") for (int r = 0; r < 16; ++r) { const int orow = crow(r, hi);                                                     \
            _Pragma("unroll") for (int d0 = 0; d0 < 4; ++d0) { const float v = o[d0][r] * rli[r]; const float vn = __shfl_xor(v, 1);       \
                if ((r32 & 1) == 0) *(__attribute__((address_space(1))) unsigned*)(Ob_ + (size_t)orow * opitch + d0 * 32 + r32) = cvtpk(v, vn); } } } while (0)

template <bool SEL>
__device__ __forceinline__ void attn_branch(const bf16_t* Qw, const bf16_t* Kh, const bf16_t* Vh, bf16_t* Ow, int opitch, int P0, int qrel, int W, const unsigned* selg, char* lds) {
    int tid = threadIdx.x; asm volatile("" : "+v"(tid));
    const int lane = tid & 63, r32 = lane & 31, hi = lane >> 5;
    const int j_lo = SEL ? 0 : swa_jlo(P0, W);
    const int j_hi = (P0 + UROWS - 1) / KVBLK + 1;
    const int NT = j_hi - j_lo;
    const int qlo = P0 + qrel, qm = qlo + r32 - 4 * hi;
    char* V_lds = lds + L_V; char* K_lds = lds + L_K;
    float* ws = (float*)(lds + L_WS) + (tid >> 6) * 64; float* li_l = ws; float* al_l = ws + 32;
    unsigned selbits = 0xffffffffu; if (SEL) selbits = selg[qrel + r32];
    float m_reg = -1e30f, l_reg = 0; f32x16 o[4] = {};
    const int sr = tid >> 4, sc = (tid & 15) * 8, vst0 = v_st(sr, sc), vst1 = v_st(32 + sr, sc), kws = KSWZ(sr, sc * 2);
    const int vb0 = (int)(uintptr_t)V_lds + v_rd_base(lane);
    bf16x8 qr[4]; char* qf = lds + L_QF + (tid >> 6) * 4096 + lane * 16;
#pragma unroll
    for (int d0 = 0; d0 < 4; ++d0) { qr[d0] = *(const bf16x8*)(Qw + (size_t)r32 * D + d0 * 16 + hi * 8);
        *(bf16x8*)(qf + d0 * 1024) = *(const bf16x8*)(Qw + (size_t)r32 * D + (d0 + 4) * 16 + hi * 8); }
    bf16x8 st_v0, st_v1, st_k0, st_k1;
#define RESC(a) do { if (__any((a) < 1.f)) { if (hi == 0) al_l[r32] = (a); asm volatile("s_waitcnt lgkmcnt(0)" ::: "memory");              \
                     _Pragma("unroll") for (int d_ = 0; d_ < 4; ++d_) _Pragma("unroll") for (int r = 0; r < 16; ++r) o[d_][r] *= al_l[crow(r, hi)]; } } while (0)
#define KBASE(t) ((j_lo + (t)) * KVBLK)
#define MASKT(P0_, P1_, t) do { const int kb_ = KBASE(t); if (kb_ + KVBLK - 1 > qlo || kb_ <= qlo + QBLK - 1 - W) mask_tile(P0_, P1_, qm - kb_, (unsigned)W);  \
        if (SEL) { const bool off_ = ((selbits >> (j_lo + (t))) & 1u) == 0u; const float NEG_ = -__builtin_inff();                                          \
            _Pragma("unroll") for (int r = 0; r < 16; ++r) { P0_[r] = off_ ? NEG_ : P0_[r]; P1_[r] = off_ ? NEG_ : P1_[r]; } } } while (0)
    f32x16 pA0, pA1, pB0, pB1; float mnA, mnB, alA, alB; bf16x8 pa0, pa1, pa2, pa3;
    SLOAD_H(Kh, Vh, KBASE(0)); VMW(); SWRITE_HK(0);
    __syncthreads();
    SWRITE_HV(0); SBAR();
    if (NT > 1) SLOAD_H(Kh, Vh, KBASE(1));
    SBAR(); qkt2<0>(pA0, pA1, K_lds, r32, hi, qr, qf);
    MASKT(pA0, pA1, 0); partialSM(pA0, pA1, m_reg, mnA, alA);
    if (NT > 1) { VMW(); SWRITE_H(1); }
    __syncthreads();
#define HALF_STEP(PX0, PX1, mnX, alX, PY0, PY1, alY, t, KB, VB, SB) do {                                                      \
        SBAR(); qkt2<KB>(PX0, PX1, K_lds, r32, hi, qr, qf);                                                                        \
        finishSM(PY0, PY1, alY, l_reg, pa0, pa1, pa2, pa3); SBAR();                                                           \
        if ((t) + 1 < NT) { SLOAD_H(Kh, Vh, KBASE((t) + 1)); SBAR(); }                                                        \
        pv_tile<VB>(o, vb0, pa0, pa1, pa2, pa3); MASKT(PX0, PX1, (t)); partialSM(PX0, PX1, m_reg, mnX, alX);                  \
        __syncthreads();                                                                                                      \
        if ((t) + 1 < NT) { VMW(); SWRITE_H(SB); }                                                                            \
        RESC(alX); __syncthreads(); } while (0)
    for (int t = 1; t + 1 < NT; t += 2) {
        HALF_STEP(pB0, pB1, mnB, alB, pA0, pA1, alA, t, 1, 0, 0);
        HALF_STEP(pA0, pA1, mnA, alA, pB0, pB1, alB, t + 1, 0, 1, 1);
    }
    const bool even = (NT & 1) == 0;
    if (even) { SBAR(); qkt2<1>(pB0, pB1, K_lds, r32, hi, qr, qf); SBAR(); }
    finishSM(pA0, pA1, alA, l_reg, pa0, pa1, pa2, pa3); SBAR();
    pv_tile<0>(o, vb0, pa0, pa1, pa2, pa3);
    if (even) { MASKT(pB0, pB1, NT - 1); partialSM(pB0, pB1, m_reg, mnB, alB); __syncthreads(); RESC(alB);
        finishSM(pB0, pB1, alB, l_reg, pa0, pa1, pa2, pa3); SBAR(); pv_tile<1>(o, vb0, pa0, pa1, pa2, pa3); }
    const float l_inv = __builtin_amdgcn_rcpf(l_reg);
    STORE_O();
    __syncthreads();
#undef RESC
#undef KBASE
#undef MASKT
#undef HALF_STEP
}

__device__ __forceinline__ void cmp_branch(const bf16_t* Qw, const bf16_t* Kc, const bf16_t* Vc, bf16_t* Ow, int opitch, int P0, int qrel, int g, unsigned* selg, char* lds) {
    int tid = threadIdx.x; asm volatile("" : "+v"(tid));
    const int lane = tid & 63, r32 = lane & 31, hi = lane >> 5;
    char* V_lds = lds + L_V; char* K_lds = lds + L_K;
    float* ws = (float*)(lds + L_WS) + (tid >> 6) * 64; float* li_l = ws;
    float* imp = (float*)(lds + L_IMP); unsigned* selb = (unsigned*)(lds + L_SELB);
    const int sr = tid >> 4, sc = (tid & 15) * 8, vst0 = v_st(sr, sc), vst1 = v_st(32 + sr, sc), kws = KSWZ(sr, sc * 2);
    const int vb0 = (int)(uintptr_t)V_lds + v_rd_base(lane);
    bf16x8 qr[8];
#pragma unroll
    for (int d0 = 0; d0 < 8; ++d0) qr[d0] = *(const bf16x8*)(Qw + (size_t)r32 * D + d0 * 16 + hi * 8);
    bf16x8 st_v0, st_v1, st_k0, st_k1;
    SLOAD_H(Kc, Vc, 0); VMW(); SWRITE_H(0); SBAR();
    SLOAD_H(Kc, Vc, 64); VMW(); SWRITE_H(1);
    __syncthreads();
    f32x16 pA0, pA1, pB0, pB1;
    qkt<0>(pA0, pA1, K_lds, r32, hi, qr); SBAR(); qkt<1>(pB0, pB1, K_lds, r32, hi, qr); SBAR();
    const int tpos = P0 + qrel + r32, nmax = (tpos - 31) >> 4;
    const float NEG = -__builtin_inff();
    const int nm = nmax - 4 * hi;
#pragma unroll
    for (int r = 0; r < 16; ++r) { const int c = (r & 3) + 8 * (r >> 2);
        if (c > nm) pA0[r] = NEG; if (c + 32 > nm) pA1[r] = NEG; if (c + 64 > nm) pB0[r] = NEG; if (c + 96 > nm) pB1[r] = NEG; }
    float pmax = NEG;
#pragma unroll
    for (int r = 0; r < 16; ++r) pmax = fmaxf(fmaxf(pmax, pA0[r]), fmaxf(pA1[r], fmaxf(pB0[r], pB1[r])));
    { auto rr = __builtin_amdgcn_permlane32_swap(__float_as_uint(pmax), __float_as_uint(pmax), false, false);
      pmax = fmaxf(__uint_as_float(rr[0]), __uint_as_float(rr[1])); }
    constexpr float C2 = 1.4426950408889634f * SCALE;
    const float mnL = -fmaxf(pmax, -1e30f) * C2;
    float ps = 0.f;
#pragma unroll
    for (int r = 0; r < 16; ++r) { pA0[r] = __builtin_amdgcn_exp2f(fmaf(pA0[r], C2, mnL)); pA1[r] = __builtin_amdgcn_exp2f(fmaf(pA1[r], C2, mnL));
        pB0[r] = __builtin_amdgcn_exp2f(fmaf(pB0[r], C2, mnL)); pB1[r] = __builtin_amdgcn_exp2f(fmaf(pB1[r], C2, mnL));
        ps += (pA0[r] + pA1[r]) + (pB0[r] + pB1[r]); }
    { auto rr = __builtin_amdgcn_permlane32_swap(__float_as_uint(ps), __float_as_uint(ps), false, false);
      ps = __uint_as_float(rr[0]) + __uint_as_float(rr[1]); }
    const float l_inv = ps > 0.f ? 1.0f / ps : 0.f; SBAR();
#if !defined(CMP_NO_IMP)
    { float A[16], Bo[16], Bp[16];
#define IMPG(P, T) _Pragma("unroll") for (int rq = 0; rq < 4; ++rq) { const float h3 = 0.5f * P[4 * rq + 3]; A[(T) * 4 + rq] = (P[4 * rq] + P[4 * rq + 1]) + (P[4 * rq + 2] + h3); Bo[(T) * 4 + rq] = h3; }
      IMPG(pA0, 0) IMPG(pA1, 1) IMPG(pB0, 2) IMPG(pB1, 3)
#undef IMPG
#pragma unroll
      for (int i = 0; i < 16; ++i) Bp[i] = __shfl_xor(Bo[i], 32);
      float* dst = imp + ((size_t)g * UROWS + qrel + r32) * 32 + hi;
#pragma unroll
      for (int i = 0; i < 16; ++i) { const float prev = i > 0 ? Bp[i - 1] : 0.f; const float v = (A[i] + (hi ? Bp[i] : prev)) * l_inv; dst[2 * i] = v; } }
#endif
    SBAR(); bf16x8 pa0, pa1, pa2, pa3; f32x16 o[4] = {};
#if !defined(CMP_NO_PV)
    PK4(pA0, 0, pa0); PK4(pA0, 8, pa1); PK4(pA1, 0, pa2); PK4(pA1, 8, pa3); SBAR();
    pv_tile<0>(o, vb0, pa0, pa1, pa2, pa3);
    PK4(pB0, 0, pa0); PK4(pB0, 8, pa1); PK4(pB1, 0, pa2); PK4(pB1, 8, pa3); SBAR();
    pv_tile<1>(o, vb0, pa0, pa1, pa2, pa3); SBAR();
#endif
    STORE_O(); SBAR();
    __syncthreads();
#if !defined(CMP_NO_TOPK)
    { const int token = tid >> 2, sub = tid & 3; const float* i0 = imp + (size_t)token * 32; const float* i1 = imp + (size_t)(UROWS + token) * 32;
      const int bt = (P0 + token) >> 6; float v[32];
#pragma unroll
      for (int i = 0; i < 32; ++i) { const float x = i0[i] + i1[i]; const bool forced = (i == 0) || (i == bt) || (i == bt - 1); v[i] = forced ? 1e30f : (i <= bt ? x : -1e30f); }
      unsigned bits = 0u;
#pragma unroll
      for (int jj = 0; jj < 8; ++jj) { const int j = 4 * jj + sub; const float xj = i0[j] + i1[j]; const bool forced = (j == 0) || (j == bt) || (j == bt - 1);
          const float vj = forced ? 1e30f : (j <= bt ? xj : -1e30f); int cnt = 0;
#pragma unroll
          for (int i = 0; i < 32; ++i) { bool c;
              if ((i >> 2) < jj) c = v[i] >= vj; else if ((i >> 2) > jj) c = v[i] > vj; else c = ((i & 3) < sub) ? (v[i] >= vj) : (v[i] > vj);
              cnt += c ? 1 : 0; }
          if (cnt < 16) bits |= 1u << j;
          SBAR(); }
      bits |= __shfl_xor(bits, 1); bits |= __shfl_xor(bits, 2);
      if (sub == 0) { selb[token] = bits; if (selg) selg[token] = bits; } }
#endif
    asm volatile("s_waitcnt vmcnt(0)" ::: "memory");
    __syncthreads();
}
#undef ROW
#undef SLOAD_H
#undef SWRITE_HK
#undef SWRITE_HV
#undef SWRITE_H
#undef STORE_O
#undef PK4
#undef VMW
#undef SBAR
#undef KSWZ
}
constexpr int NWAVES = 8;
#ifndef MK_N_LAUNCHES
#define MK_N_LAUNCHES 1
#endif
constexpr int N_PHASES = 12;
constexpr int N_LAUNCHES = MK_N_LAUNCHES;
constexpr size_t MiB = 1u << 20;
constexpr size_t WS_CTL = 0, CTL_ZERO_BYTES = 1 * MiB;
constexpr size_t WS_MOD = 256 * 1024;
constexpr size_t WS_PEB = 704 * 1024;
constexpr size_t WS_WIN = 2 * MiB, WS_WO = 10 * MiB, WS_WFF1 = 12 * MiB, WS_WFF2 = 20 * MiB, WS_CKW1 = 28 * MiB, WS_CVW1 = 30 * MiB;
constexpr size_t WS_TAB = 32 * MiB;
constexpr size_t WS_XN = 48 * MiB;
constexpr size_t WS_RG = 112 * MiB;
constexpr size_t WS_HID = 116 * MiB;
constexpr size_t WS_KCMP = 120 * MiB, WS_VCMP = 121 * MiB;
constexpr size_t WS_SEL = 122 * MiB;
constexpr size_t WS_H = 124 * MiB;
constexpr size_t WS_GLA = 124 * MiB;
constexpr size_t WS_NQ = 220 * MiB;
constexpr size_t WS_KV = 252 * MiB, KV_STRIDE_B = 17 * MiB;
constexpr size_t WS_OBR = 380 * MiB, OBR_STRIDE_B = 32 * MiB;
constexpr size_t WS_END = 476 * MiB;
static_assert(WS_KV + 6 * KV_STRIDE_B <= WS_OBR && WS_H + (size_t)MTOK * DFF * 2 <= WS_OBR && WS_MOD + 16 * NMOD * 4 <= WS_PEB && WS_PEB + 2048 <= CTL_ZERO_BYTES, "d_ws map");
constexpr int CW_BAR = 4096;
constexpr int RING_BYTES = 131072, LDSCTL_OFF = RING_BYTES, MISC_OFF = LDSCTL_OFF + 320, LDS_BYTES = 147456;
static_assert(nsa::L_END <= RING_BYTES, "attention scratch inside the ring region");

#define GAS __attribute__((address_space(1)))
#define LAS __attribute__((address_space(3)))
typedef unsigned short bf16;
typedef unsigned v4u __attribute__((ext_vector_type(4)));
typedef unsigned v2u __attribute__((ext_vector_type(2)));
typedef float f32x4 __attribute__((ext_vector_type(4)));
typedef GAS unsigned gu32;
#define RLX_AGENT __ATOMIC_RELAXED, __HIP_MEMORY_SCOPE_AGENT
#define LDS_WAIT() asm volatile("s_waitcnt lgkmcnt(0)" ::: "memory")
#define VM_WAIT() asm volatile("s_waitcnt vmcnt(0)" ::: "memory")
__device__ __forceinline__ unsigned f2bf(float f) { unsigned u = __builtin_bit_cast(unsigned, f); return (u + 0x7fffu + ((u >> 16) & 1u)) >> 16; }
__device__ __forceinline__ unsigned pk2(float lo, float hi) { return f2bf(lo) | (f2bf(hi) << 16); }
__device__ __forceinline__ float bf2f(unsigned short u) { return __builtin_bit_cast(float, (unsigned)u << 16); }
__device__ __forceinline__ float bflo(unsigned w) { return __builtin_bit_cast(float, w << 16); }
__device__ __forceinline__ float bfhi(unsigned w) { return __builtin_bit_cast(float, w & 0xffff0000u); }
#define XB_TMO      128
#define XB_XCNT(j)  (256  + 64 * (j))
#define XB_XSUB(j)  (1280 + 64 * (j))
#define XB_XGEN(j)  (2304 + 64 * (j))
#define XB_TOP      3328
#define XB_TOPGEN   3392
#define XCD_BAR_WORDS 3456
#define XB_SPIN_CAP (1u << 18)

__device__ __forceinline__ unsigned xb_ld(unsigned* p)              { return __hip_atomic_load(p, __ATOMIC_RELAXED, __HIP_MEMORY_SCOPE_AGENT); }
__device__ __forceinline__ unsigned xb_add(unsigned* p, unsigned v) { return __hip_atomic_fetch_add(p, v, __ATOMIC_RELAXED, __HIP_MEMORY_SCOPE_AGENT); }
__device__ __forceinline__ unsigned xb_xcc_id() { return (unsigned)__builtin_amdgcn_s_getreg((3 << 11) | 20) & 0xFu; }
#define XB_SPIN(cond, bar) do { unsigned _sp = 0; while (cond) { __builtin_amdgcn_s_sleep(1); \
    if ((++_sp & 255u) == 0u) { if (xb_ld(&(bar)[XB_TMO])) break; if (_sp > XB_SPIN_CAP) { atomicAdd(&(bar)[XB_TMO], 1u); break; } } } } while (0)

struct XcdBarrier {
    unsigned* bar; unsigned x;
    volatile LAS unsigned* st;
};

__device__ __forceinline__ XcdBarrier xcd_barrier_post(unsigned* bar, volatile LAS unsigned* st) {
    XcdBarrier b; b.bar = bar; b.x = xb_xcc_id(); b.st = st;
    if (threadIdx.x == 0) (void)xb_add(&bar[XB_XCNT(b.x)], 1u);
    return b;
}
__device__ __forceinline__ void xcd_barrier_complete(unsigned* bar, unsigned x, unsigned& nloc, unsigned& nx) {
    const unsigned G = gridDim.x * gridDim.y * gridDim.z;
    unsigned sum, cnt, mine, sp = 0u;
    for (;;) {
        sum = 0u; cnt = 0u; mine = 0u;
#pragma unroll
        for (unsigned j = 0; j < 16; ++j) { const unsigned c = xb_ld(&bar[XB_XCNT(j)]); sum += c; cnt += (c > 0u) ? 1u : 0u; mine = (j == x) ? c : mine; }
        if (sum == G) break;
        __builtin_amdgcn_s_sleep(1);
        if ((++sp & 255u) == 0u) { if (xb_ld(&bar[XB_TMO])) break; if (sp > XB_SPIN_CAP) { atomicAdd(&bar[XB_TMO], 1u); break; } }
    }
    nloc = mine > 0u ? mine : 1u; nx = cnt > 0u ? cnt : 1u;
}

__device__ __forceinline__ void xcd_barrier(const XcdBarrier& b) {
    asm volatile("s_waitcnt vmcnt(0)" ::: "memory");
    __syncthreads();
    if (threadIdx.x == 0) {
        unsigned* bar = b.bar;
        __builtin_amdgcn_s_waitcnt(0);
        unsigned nloc = b.st[0], nx = b.st[1];
        if (nloc == 0u) { xcd_barrier_complete(bar, b.x, nloc, nx); b.st[0] = nloc; b.st[1] = nx; }
        const unsigned old = xb_add(&bar[XB_XSUB(b.x)], 1u);
        const unsigned gen = old / nloc;
        if (old + 1u == (gen + 1u) * nloc) {
            __builtin_amdgcn_fence(__ATOMIC_RELEASE, "agent");
            asm volatile("s_waitcnt vmcnt(0)" ::: "memory");
            const unsigned og = xb_add(&bar[XB_TOP], 1u);
            const unsigned tg = og / nx;
            if (og + 1u == (tg + 1u) * nx) xb_add(&bar[XB_TOPGEN], 1u);
            else XB_SPIN(xb_ld(&bar[XB_TOPGEN]) == tg, bar);
            __builtin_amdgcn_fence(__ATOMIC_ACQUIRE, "agent");
            xb_add(&bar[XB_XGEN(b.x)], 1u);
            asm volatile("s_waitcnt vmcnt(0)" ::: "memory");
        } else {
            XB_SPIN(xb_ld(&bar[XB_XGEN(b.x)]) == gen, bar);
            __builtin_amdgcn_fence(__ATOMIC_ACQUIRE, "agent");
            asm volatile("s_waitcnt vmcnt(0)" ::: "memory");
        }
    }
    __syncthreads();
}
struct Args { const float* in[22]; float* out; unsigned char* ws; int ph_lo, ph_hi, li, pad; };
__device__ __forceinline__ float wave_sum(float v) {
#pragma unroll
    for (int o = 1; o < 64; o <<= 1) v += __shfl_xor(v, o);
    return v;
}
__device__ __forceinline__ float siluf(float x) { return x / (1.f + expf(-x)); }
__device__ __forceinline__ int ropeperm(int pp) { return 64 * ((pp >> 2) & 1) + 16 * (pp >> 5) + 4 * ((pp >> 3) & 3) + (pp & 3); }
__device__ __forceinline__ int inproj_src(int pr, float& scale) {
    scale = 1.f; const int pn = pr >> 8, p = pr & 255;
    if (pn == 0) { scale = 0.125f; return p; }
    if (pn == 1) return 256 + p;
    if (pn <= 3) return 512 + (pn - 2) * 256 + p;
    if (pn <= 5) return 1024 + (pn - 4) * 256 + p;
    if (pn <= 7) return 1552 + (2 * (pn - 6) + (p >> 7)) * 128 + ropeperm(p & 127);
    if (pn == 8) return 2064 + (p >> 7) * 128 + ropeperm(p & 127);
    if (pn == 9) return 2320 + p;
    if (pn == 10) return 2576 + (p >> 7) * 128 + ropeperm(p & 127);
    if (pn == 11) return 2832 + p;
    if (pn == 12) return 3088 + (p >> 7) * 128 + ropeperm(p & 127);
    if (pn == 13) return 3344 + p;
    return p < 16 ? 1536 + p : (p < 28 ? 3600 + (p - 16) : -1);
}
template <int MODE>
__device__ __forceinline__ void transpose_item(const float* W, int ldw, int K, bf16* WT, int k0, int n0, LAS float* scr, int lane) {
    int src = n0 + (lane & 31); float sc = 1.f;
    if (MODE == 1) src = inproj_src(n0 + (lane & 31), sc);
#pragma unroll 8
    for (int i = 0; i < 32; ++i) { const int kk = 2 * i + (lane >> 5); float v = 0.f; if (src >= 0) v = W[(size_t)(k0 + kk) * ldw + src] * sc; scr[kk * 33 + (lane & 31)] = v; }
    LDS_WAIT(); asm volatile("" ::: "memory");
    const int c = lane & 7;
#pragma unroll
    for (int j = 0; j < 4; ++j) { const int n = (lane >> 3) + 8 * j; const LAS float* s = scr + (8 * c) * 33 + n;
        v4u o; o.x = pk2(s[0 * 33], s[1 * 33]); o.y = pk2(s[2 * 33], s[3 * 33]); o.z = pk2(s[4 * 33], s[5 * 33]); o.w = pk2(s[6 * 33], s[7 * 33]);
        *(GAS v4u*)(WT + (size_t)(n0 + n) * K + k0 + 8 * c) = o; }
    LDS_WAIT(); asm volatile("" ::: "memory");
}
__device__ __forceinline__ void norm_mod_row(const float* xrow, const float* g, const float* sc, const float* sh, bf16* orow, int lane) {
    const GAS f32x4* xr = (const GAS f32x4*)xrow + lane; f32x4 v[4]; float ss = 0.f;
#pragma unroll
    for (int j = 0; j < 4; ++j) { v[j] = xr[64 * j]; ss += (v[j].x * v[j].x + v[j].y * v[j].y) + (v[j].z * v[j].z + v[j].w * v[j].w); }
    const float rstd = 1.f / sqrtf(wave_sum(ss) * (1.f / DM) + RMS_EPS);
    GAS unsigned long long* o8 = (GAS unsigned long long*)orow + lane;
#pragma unroll
    for (int j = 0; j < 4; ++j) { const int col = 4 * (lane + 64 * j); const f32x4 gv = *(const f32x4*)(g + col), sv = *(const GAS f32x4*)(sc + col), hv = *(const GAS f32x4*)(sh + col);
        const f32x4 y = v[j] * rstd * gv * (sv + 1.0f) + hv;
        o8[64 * j] = (unsigned long long)pk2(y.x, y.y) | ((unsigned long long)pk2(y.z, y.w) << 32); }
}

__device__ __forceinline__ void phase0(const Args& a, LAS unsigned char* lds, int tid, int lane, int wave, int vcu, int G) {
    unsigned char* ws = a.ws;
    { LAS float* sl = (LAS float*)lds;
      const float* c = a.in[1];
      for (int i = tid; i < 16 * 1024; i += NWAVES * 64) { const int b = i >> 10, k = i & 1023; sl[k * 16 + b] = siluf(c[i]); }
      __syncthreads();
      const int gt = (int)blockIdx.x * (NWAVES * 64) + tid;
      float* MOD = (float*)(ws + WS_MOD); float* PEB = (float*)(ws + WS_PEB);
      for (int id = gt; id < 6144 * 16 + 8192; id += G * NWAVES * 64) {
        if (id < 6144 * 16) { const int j = id % 6144, sli = id / 6144; const float* w = a.in[3] + (size_t)(sli * 64) * 6144 + j;
            float acc[16];
#pragma unroll
            for (int b = 0; b < 16; ++b) acc[b] = 0.f;
            for (int kk = 0; kk < 64; ++kk) { const float wv = w[(size_t)kk * 6144]; const LAS f32x4* sp = (const LAS f32x4*)(sl + (sli * 64 + kk) * 16);
#pragma unroll
                for (int q = 0; q < 4; ++q) { const f32x4 s4 = sp[q];
#pragma unroll
                    for (int i = 0; i < 4; ++i) acc[4 * q + i] += s4[i] * wv; } }
            const float bias = sli == 0 ? a.in[4][j] : 0.f;
#pragma unroll
            for (int b = 0; b < 16; ++b) atomicAdd(&MOD[b * 6144 + j], acc[b] + bias);
        } else { const int id2 = id - 6144 * 16, t = id2 >> 12, rem = id2 & 4095, j = rem & 255, sli = rem >> 8;
            const float* pe = a.in[10 + t] + sli * 256; const float* w1 = a.in[12 + 2 * t] + (size_t)(sli * 256) * 256 + j; float acc = 0.f;
            for (int kk = 0; kk < 256; ++kk) acc += pe[kk] * w1[(size_t)kk * 256];
            atomicAdd(&PEB[t * 256 + j], acc); }
      }
      __syncthreads(); }
    LAS float* scr = (LAS float*)(lds + wave * 16384);
    const int gw = vcu * NWAVES + wave, NGW = G * NWAVES;
    constexpr int I_IN = 16 * 120, I_O = 16 * 32, I_1 = 16 * 128, I_2 = 64 * 32, I_C = 64 * 8;
    for (int it = gw; it < I_IN + I_O + I_1 + I_2 + 2 * I_C; it += NGW) {
        int r = it;
        if (r < I_IN) { transpose_item<1>(a.in[6], DIN, DM, (bf16*)(ws + WS_WIN), 64 * (r / 120), 32 * (r % 120), scr, lane); continue; } r -= I_IN;
        if (r < I_O) { transpose_item<0>(a.in[17], DM, DM, (bf16*)(ws + WS_WO), 64 * (r / 32), 32 * (r % 32), scr, lane); continue; } r -= I_O;
        if (r < I_1) { transpose_item<0>(a.in[19], DFF, DM, (bf16*)(ws + WS_WFF1), 64 * (r / 128), 32 * (r % 128), scr, lane); continue; } r -= I_1;
        if (r < I_2) { transpose_item<0>(a.in[20], DM, DFF, (bf16*)(ws + WS_WFF2), 64 * (r / 32), 32 * (r % 32), scr, lane); continue; } r -= I_2;
        if (r < I_C) { transpose_item<0>(a.in[12], 256, 4096, (bf16*)(ws + WS_CKW1), 64 * (r / 8), 32 * (r % 8), scr, lane); continue; } r -= I_C;
        transpose_item<0>(a.in[14], 256, 4096, (bf16*)(ws + WS_CVW1), 64 * (r / 8), 32 * (r % 8), scr, lane);
    }
    { const int* pos = (const int*)a.in[2]; float* tab = (float*)(ws + WS_TAB);
      const float inv = exp2f(-(float)lane * (13.287712379549449f / 64.f));
      for (int m = gw; m < MTOK; m += NGW) { const float ang = (float)pos[m] * inv; double rev = (double)ang * 0.15915494309189535; rev -= rint(rev);
          const float r = (float)rev; typedef float f32x2 __attribute__((ext_vector_type(2)));
          *(GAS f32x2*)(tab + ((size_t)m * 64 + lane) * 2) = (f32x2){__builtin_amdgcn_cosf(r), __builtin_amdgcn_sinf(r)}; } }
}
__device__ __forceinline__ void gla_scalar_item(const Args& a, int item, int lane, LAS float* sq) {
    LAS float* sk = sq + 4096; LAS float* sa = sq + 8192; LAS float* sv = sq + 12288;
    const int bh = item >> 1, b = bh >> 2, h = bh & 3, e = (item & 1) * 64 + lane;
    const bf16* gla = (const bf16*)(a.ws + WS_GLA); const float* rg = (const float*)(a.ws + WS_RG); bf16* mix = (bf16*)(a.ws + WS_XN);
    float wa[16];
#pragma unroll
    for (int r = 0; r < 16; ++r) wa[r] = a.in[7][r * 256 + h * 64 + lane];
    const float ba = a.in[8][h * 64 + lane];
    float S[64];
#pragma unroll
    for (int d = 0; d < 64; ++d) S[d] = 0.f;
    for (int c = 0; c < 32; ++c) { const size_t m0 = (size_t)b * SEQ + c * 64;
#pragma unroll 4
        for (int tt = 0; tt < 64; ++tt) { const size_t m = m0 + tt;
            const float q = bf2f(gla[m * 1536 + h * 64 + lane]), k = bf2f(gla[m * 1536 + 256 + h * 64 + lane]), v = bf2f(gla[m * 1536 + 512 + h * 128 + e]);
            const float grv = rg[m * 32 + (lane & 15)]; float z = ba;
#pragma unroll
            for (int r = 0; r < 16; ++r) z += __shfl(grv, r) * wa[r];
            const float ls = fminf(z, 0.f) - log1pf(expf(-fabsf(z)));
            sq[tt * 64 + lane] = q; sk[tt * 64 + lane] = k; sa[tt * 64 + lane] = expf(ls * (1.f / 16.f)); sv[tt * 64 + lane] = v; }
        LDS_WAIT(); asm volatile("" ::: "memory");
        for (int tt = 0; tt < 64; ++tt) { const float v = sv[tt * 64 + lane]; float o = 0.f;
#pragma unroll
            for (int d4 = 0; d4 < 16; ++d4) { const f32x4 q4 = *(const LAS f32x4*)(sq + tt * 64 + 4 * d4), k4 = *(const LAS f32x4*)(sk + tt * 64 + 4 * d4), a4 = *(const LAS f32x4*)(sa + tt * 64 + 4 * d4);
#pragma unroll
                for (int i = 0; i < 4; ++i) { S[4 * d4 + i] = a4[i] * S[4 * d4 + i] + k4[i] * v; o += q4[i] * S[4 * d4 + i]; } }
            mix[(m0 + tt) * 1024 + h * 128 + e] = (bf16)f2bf(o); }
        LDS_WAIT(); asm volatile("" ::: "memory"); }
}
__global__ void __launch_bounds__(NWAVES * 64, 2) fwd_kernel(Args args) {
    extern __shared__ __attribute__((aligned(16))) unsigned char lds_g[];
    LAS unsigned char* lds = (LAS unsigned char*)lds_g;
    volatile LAS unsigned* MISC = (volatile LAS unsigned*)(lds + MISC_OFF);
    const int tid = threadIdx.x, lane = tid & 63, wave = __builtin_amdgcn_readfirstlane(tid >> 6);
    const int G = gridDim.x; const int bx = blockIdx.x; const int vcu = (G % 8 == 0) ? (bx % 8) * (G / 8) + bx / 8 : bx;
    unsigned char* ws = args.ws; gu32* ctl = (gu32*)(ws + WS_CTL);
    for (int u = tid; u < (LDS_BYTES - LDSCTL_OFF) / 4; u += NWAVES * 64) ((LAS unsigned*)(lds + LDSCTL_OFF))[u] = 0u;
    __syncthreads();
    XcdBarrier bar; bar.bar = (unsigned*)(ctl + CW_BAR) + args.li * XCD_BAR_WORDS; bar.x = 0; bar.st = nullptr;
    if (N_LAUNCHES != N_PHASES) bar = xcd_barrier_post((unsigned*)(ctl + CW_BAR) + args.li * XCD_BAR_WORDS, MISC + 8);
    const int lo = args.ph_lo, hi = args.ph_hi;
#ifndef PH_MASK
#define PH_MASK 0xfff
#endif
#define IN(k) (((PH_MASK >> (k)) & 1) && lo <= (k) && (k) < hi)
#define SEAM(k) do { if (IN(k) && IN((k) + 1)) xcd_barrier(bar); } while (0)
    const int gw = vcu * NWAVES + wave, NGW = G * NWAVES;
    float* MOD = (float*)(ws + WS_MOD);
    bf16* XN = (bf16*)(ws + WS_XN);

    if (IN(0)) { phase0(args, lds, tid, lane, wave, vcu, G); } SEAM(0);
    if (IN(1)) { for (int m = gw; m < MTOK; m += NGW) { const int b = m / SEQ; norm_mod_row(args.in[0] + (size_t)m * DM, args.in[5], MOD + b * NMOD + 1024, MOD + b * NMOD, XN + (size_t)m * DM, lane); } } SEAM(1);
    if (IN(2)) { pg8::Gemm g{XN, (const bf16*)(ws + WS_WIN), MTOK, NPROJ, DM, DM}; pg8::StaticOrder S; S.init(MTOK, NPROJ, G, bx);
        pg8::EpiInProj E{(bf16*)(ws + WS_GLA), (bf16*)(ws + WS_NQ), (bf16*)(ws + WS_KV), KV_STRIDE_B / 2, (float*)(ws + WS_RG), (const float*)(ws + WS_TAB)};
        pg8::gemm_phase<pg8::EpiInProj, pg8::StaticOrder, true, true>(lds, g, S, E); } SEAM(2);
    if (IN(3)) {
        if (bx < 32) { const int t = bx >> 4;
            pg8::Gemm g{(const bf16*)(ws + WS_KV + (size_t)t * KV_STRIDE_B), (const bf16*)(ws + (t ? WS_CVW1 : WS_CKW1)), 4096, 256, 4096, 2048}; pg8::OneUnit S{bx & 15, 0};
            pg8::EpiActBf16<1> E{(bf16*)(ws + WS_HID) + (size_t)t * 4096 * 256, 256, (const float*)(ws + WS_PEB) + t * 256};
            pg8::gemm_phase<pg8::EpiActBf16<1>, pg8::OneUnit, true, true>(lds, g, S, E);
        } else if (bx < 160) { if (wave == 0) gla_scalar_item(args, bx - 32, lane, (LAS float*)lds); }
    } SEAM(3);
    if (IN(4)) { LAS float* hrow = (LAS float*)(lds + wave * 1024);
        for (int item = gw; item < 8192; item += NGW) { const int t = item >> 12, m = item & 4095;
            const v2u hv = *(const GAS v2u*)((const bf16*)(ws + WS_HID) + ((size_t)t * 4096 + m) * 256 + 4 * lane);
            *(LAS f32x4*)(hrow + 4 * lane) = (f32x4){bflo(hv.x), bfhi(hv.x), bflo(hv.y), bfhi(hv.y)};
            LDS_WAIT(); asm volatile("" ::: "memory");
            const float* w2 = args.in[13 + 2 * t]; float a0 = 0.f, a1 = 0.f;
#pragma unroll 4
            for (int j4 = 0; j4 < 64; ++j4) { const f32x4 h4 = *(const LAS f32x4*)(hrow + 4 * j4);
#pragma unroll
                for (int i = 0; i < 4; ++i) { a0 += h4[i] * w2[(4 * j4 + i) * 128 + lane]; a1 += h4[i] * w2[(4 * j4 + i) * 128 + 64 + lane]; } }
            bf16* o = (bf16*)(ws + (t ? WS_VCMP : WS_KCMP)) + (size_t)m * 128; o[lane] = (bf16)f2bf(a0); o[64 + lane] = (bf16)f2bf(a1);
            LDS_WAIT(); asm volatile("" ::: "memory"); } } SEAM(4);
    if (IN(5)) { const bf16* NQ = (const bf16*)(ws + WS_NQ); const int g = wave >> 2, qrel = 32 * (wave & 3);
        unsigned* SELG = (unsigned*)(ws + WS_SEL);
#ifndef NSA_PARTS
#define NSA_PARTS 7
#endif
#define NSA_UNIT_VARS const int bh = item >> 3, x = item & 7, b = bh >> 1, hk = bh & 1; const int qb = pass ? x : 15 - x, P0 = qb * 128; \
                const bf16* Qw = NQ + ((size_t)(b * 4 + 2 * hk + g) * SEQ + P0 + qrel) * 128; \
                bf16* Ow = (bf16*)(ws + WS_OBR) + (size_t)(b * SEQ + P0 + qrel) * 512 + (2 * hk + g) * 128; \
                const size_t kvo = (size_t)bh * SEQ * 128; unsigned* selg = SELG + (size_t)bh * SEQ + P0; (void)kvo; (void)Ow; (void)Qw; (void)selg;
        if (NSA_PARTS & 1) for (int item = vcu; item < 256; item += G) for (int pass = 0; pass < 2; ++pass) { NSA_UNIT_VARS
                nsa::cmp_branch(Qw, (const bf16*)(ws + WS_KCMP) + (size_t)bh * 128 * 128, (const bf16*)(ws + WS_VCMP) + (size_t)bh * 128 * 128, Ow, 512, P0, qrel, g, selg, (char*)lds_g); }
        if (NSA_PARTS & 2) for (int item = vcu; item < 256; item += G) for (int pass = 0; pass < 2; ++pass) { NSA_UNIT_VARS
                nsa::attn_branch<true>(Qw, (const bf16*)(ws + WS_KV + 2 * KV_STRIDE_B) + kvo, (const bf16*)(ws + WS_KV + 3 * KV_STRIDE_B) + kvo, Ow + OBR_STRIDE_B / 2, 512, P0, qrel, 0x40000000, selg, (char*)lds_g); }
        if (NSA_PARTS & 4) for (int item = vcu; item < 256; item += G) for (int pass = 0; pass < 2; ++pass) { NSA_UNIT_VARS
                nsa::attn_branch<false>(Qw, (const bf16*)(ws + WS_KV + 4 * KV_STRIDE_B) + kvo, (const bf16*)(ws + WS_KV + 5 * KV_STRIDE_B) + kvo, Ow + OBR_STRIDE_B, 512, P0, qrel, 512, nullptr, (char*)lds_g); }
    } SEAM(5);
    if (IN(6)) { const bf16* OBR = (const bf16*)(ws + WS_OBR); const float* rg = (const float*)(ws + WS_RG); const bf16* gla = (const bf16*)(ws + WS_GLA);
        for (int m = gw; m < MTOK; m += NGW) { const int hq = lane >> 4; float gt[3];
#pragma unroll
            for (int br = 0; br < 3; ++br) { const float z = rg[(size_t)m * 32 + 16 + hq * 3 + br]; gt[br] = 1.f / (1.f + expf(-z)); }
            float o[8];
#pragma unroll
            for (int i = 0; i < 8; ++i) o[i] = 0.f;
#pragma unroll
            for (int br = 0; br < 3; ++br) { const v4u w = *(const GAS v4u*)(OBR + (size_t)br * (OBR_STRIDE_B / 2) + (size_t)m * 512 + 8 * lane);
                o[0] += gt[br] * bflo(w.x); o[1] += gt[br] * bfhi(w.x); o[2] += gt[br] * bflo(w.y); o[3] += gt[br] * bfhi(w.y);
                o[4] += gt[br] * bflo(w.z); o[5] += gt[br] * bfhi(w.z); o[6] += gt[br] * bflo(w.w); o[7] += gt[br] * bfhi(w.w); }
            float ss = 0.f;
#pragma unroll
            for (int i = 0; i < 8; ++i) ss += o[i] * o[i];
            const float rstd = 1.f / sqrtf(wave_sum(ss) * (1.f / 512.f) + RMS_EPS);
            const f32x4 g0 = *(const f32x4*)(args.in[16] + 8 * lane), g1 = *(const f32x4*)(args.in[16] + 8 * lane + 4);
            v4u w; w.x = pk2(o[0] * rstd * g0[0], o[1] * rstd * g0[1]); w.y = pk2(o[2] * rstd * g0[2], o[3] * rstd * g0[3]);
            w.z = pk2(o[4] * rstd * g1[0], o[5] * rstd * g1[1]); w.w = pk2(o[6] * rstd * g1[2], o[7] * rstd * g1[3]);
            *(GAS v4u*)(XN + (size_t)m * DM + 512 + 8 * lane) = w;
            const v4u r = *(const GAS v4u*)(XN + (size_t)m * DM + 8 * lane); const v4u gg = *(const GAS v4u*)(gla + (size_t)m * 1536 + 1024 + 8 * lane);
            float v[8] = {bflo(r.x), bfhi(r.x), bflo(r.y), bfhi(r.y), bflo(r.z), bfhi(r.z), bflo(r.w), bfhi(r.w)};
            float q[8] = {bflo(gg.x), bfhi(gg.x), bflo(gg.y), bfhi(gg.y), bflo(gg.z), bfhi(gg.z), bflo(gg.w), bfhi(gg.w)};
            float s2 = 0.f;
#pragma unroll
            for (int i = 0; i < 8; ++i) s2 += v[i] * v[i];
            s2 += __shfl_xor(s2, 1); s2 += __shfl_xor(s2, 2); s2 += __shfl_xor(s2, 4); s2 += __shfl_xor(s2, 8);
            const float rs2 = 1.f / sqrtf(s2 * (1.f / 128.f) + RMS_EPS);
            const f32x4 h0 = *(const f32x4*)(args.in[9] + 8 * lane), h1 = *(const f32x4*)(args.in[9] + 8 * lane + 4);
            float y[8];
#pragma unroll
            for (int i = 0; i < 8; ++i) y[i] = v[i] * rs2 * (i < 4 ? h0[i & 3] : h1[i & 3]) * siluf(q[i]);
            v4u w2; w2.x = pk2(y[0], y[1]); w2.y = pk2(y[2], y[3]); w2.z = pk2(y[4], y[5]); w2.w = pk2(y[6], y[7]);
            *(GAS v4u*)(XN + (size_t)m * DM + 8 * lane) = w2; } } SEAM(6);
    if (IN(7)) { pg8::Gemm g{XN, (const bf16*)(ws + WS_WO), MTOK, DM, DM, DM}; pg8::StaticOrder S; S.init(MTOK, DM, G, bx);
        pg8::EpiResid E{args.in[0], args.out, MOD + 2048};
        pg8::gemm_phase<pg8::EpiResid, pg8::StaticOrder, true, true>(lds, g, S, E); } SEAM(7);
    if (IN(8)) { for (int m = gw; m < MTOK; m += NGW) { const int b = m / SEQ; norm_mod_row(args.out + (size_t)m * DM, args.in[18], MOD + b * NMOD + 4096, MOD + b * NMOD + 3072, XN + (size_t)m * DM, lane); } } SEAM(8);
    if (IN(9)) { pg8::Gemm g{XN, (const bf16*)(ws + WS_WFF1), MTOK, DFF, DM, DM}; pg8::StaticOrder S; S.init(MTOK, DFF, G, bx);
        pg8::EpiActBf16<2> E{(bf16*)(ws + WS_H), DFF, nullptr};
        pg8::gemm_phase<pg8::EpiActBf16<2>, pg8::StaticOrder, true, true>(lds, g, S, E); } SEAM(9);
    if (IN(10)) { pg8::Gemm g{(const bf16*)(ws + WS_H), (const bf16*)(ws + WS_WFF2), MTOK, DM, DFF, DFF}; pg8::StaticOrder S; S.init(MTOK, DM, G, bx);
        pg8::EpiResid E{args.out, args.out, MOD + 5120};
        pg8::gemm_phase<pg8::EpiResid, pg8::StaticOrder, true, true>(lds, g, S, E); } SEAM(10);
    if (IN(11)) { for (int m = gw; m < MTOK; m += NGW) { GAS f32x4* xr = (GAS f32x4*)(args.out + (size_t)m * DM) + lane; f32x4 v[4]; float ss = 0.f;
#pragma unroll
            for (int j = 0; j < 4; ++j) { v[j] = xr[64 * j]; ss += (v[j].x * v[j].x + v[j].y * v[j].y) + (v[j].z * v[j].z + v[j].w * v[j].w); }
            const float rstd = 1.f / sqrtf(wave_sum(ss) * (1.f / DM) + RMS_EPS);
#pragma unroll
            for (int j = 0; j < 4; ++j) xr[64 * j] = v[j] * rstd * *(const f32x4*)(args.in[21] + 4 * (lane + 64 * j)); } }
#undef IN
#undef SEAM
}

extern "C" void kernel_launch(void* const* d_in, const int* in_sizes, int n_in, void* d_out, int out_size, void* d_ws, size_t ws_size, hipStream_t stream) {
    static int grid = 0;
    if (grid == 0) {
        if (n_in != 22 || in_sizes[0] != MTOK * DM || out_size != MTOK * DM || ws_size < WS_END) { fprintf(stderr, "kernel_launch: unexpected shapes (n_in %d, in0 %d, out %d, ws %zu)\n", n_in, n_in > 0 ? in_sizes[0] : -1, out_size, ws_size); grid = -1; return; }
        if (hipFuncSetAttribute((const void*)fwd_kernel, hipFuncAttributeMaxDynamicSharedMemorySize, LDS_BYTES) != hipSuccess) { fprintf(stderr, "kernel_launch: hipFuncSetAttribute failed\n"); grid = -1; return; }
        int per_cu = 0;
        if (hipOccupancyMaxActiveBlocksPerMultiprocessor(&per_cu, (const void*)fwd_kernel, NWAVES * 64, LDS_BYTES) != hipSuccess || per_cu < 1) fprintf(stderr, "kernel_launch: occupancy query reports %d workgroups per CU\n", per_cu);
        (void)hipGetLastError();
        grid = 256;
    }
    if (grid < 0) return;
    if (hipMemsetAsync((char*)d_ws + WS_CTL, 0, CTL_ZERO_BYTES, stream) != hipSuccess) { fprintf(stderr, "kernel_launch: hipMemsetAsync failed\n"); return; }
    Args a{};
    for (int i = 0; i < 22; ++i) a.in[i] = (const float*)d_in[i];
    a.out = (float*)d_out; a.ws = (unsigned char*)d_ws;
    for (int li = 0; li < N_LAUNCHES; ++li) {
        a.ph_lo = (N_LAUNCHES == 1) ? 0 : li; a.ph_hi = (N_LAUNCHES == 1) ? N_PHASES : li + 1; a.li = (N_LAUNCHES == 1) ? 0 : 0;
        hipLaunchKernelGGL(fwd_kernel, dim3(grid), dim3(NWAVES * 64), LDS_BYTES, stream, a);
        const hipError_t le = hipPeekAtLastError();
        if (le != hipSuccess) { fprintf(stderr, "kernel_launch: launch %d failed: %s\n", li, hipGetErrorName(le)); break; }
    }
}
```

```cpp
#include <hip/hip_runtime.h>
#include <cstdio>
#include <cstdint>
#include <cmath>

constexpr int BATCH = 16, SEQ = 2048, DM = 1024, MTOK = BATCH * SEQ, DFF = 4096, DIN = 3612, NPROJ = 3840, NMOD = 6 * DM;
constexpr float RMS_EPS = 1e-6f;

namespace pg8 {
#define PG8_LAS __attribute__((address_space(3)))
typedef unsigned short bf16_t;
typedef short bf16x8 __attribute__((ext_vector_type(8)));
typedef float f32x4 __attribute__((ext_vector_type(4)));
typedef unsigned u32x4 __attribute__((ext_vector_type(4)));
constexpr int BM = 256, BK = 64, HALF = 128, HTB = HALF * BK * 2  , STAGE_BYTES = 8 * HTB, NXCD = 8, WGM = 8;

__host__ __device__ __forceinline__ int lds_byte(int r, int c) { const int st = (r >> 4) * 2 + (c >> 5), rr = r & 15, cc = c & 31, ob = rr * 64 + cc * 2; return st * 1024 + (ob ^ (((ob >> 9) & 1) << 5)); }
__host__ __device__ __forceinline__ void stage_rc(int b, int& R, int& C) { const int st = b / 1024, sb = b % 1024, swz = sb ^ (((sb >> 9) & 1) << 5); R = (st >> 1) * 16 + swz / 64; C = (st & 1) * 32 + (swz % 64) / 2; }
__host__ __device__ __forceinline__ int perm32(int rho) { const int n = rho >> 4, i = rho & 15; return 8 * (i >> 2) + 4 * n + (i & 3); }

struct Unit { int pm, pn; };
struct Gemm { const bf16_t* A; const bf16_t* Bt; int M, N, K, lda; };

struct StaticOrder {
    int nM, nN, nwg, G, c;
    __host__ __device__ void init(int M, int N, int G_, int c_) { nM = M / BM; nN = N / BM; nwg = nM * nN; G = G_; c = c_; }
    __host__ __device__ bool next(int i, Unit& u) const {
        const long L = (long)i * G + c; if (L >= nwg) return false;
        int wgid = (int)L; { const int q = nwg / NXCD, r = nwg % NXCD, xcd = wgid % NXCD, off = wgid / NXCD; wgid = (xcd < r ? xcd * (q + 1) : r * (q + 1) + (xcd - r) * q) + off; }
        const int nig = WGM * nN, gid = wgid / nig, fm = gid * WGM, gsz = (nM - fm) < WGM ? (nM - fm) : WGM;
        u.pm = fm + ((wgid % nig) % gsz); u.pn = (wgid % nig) / gsz; return true;
    }
    __device__ __forceinline__ void a_ready(const Unit&) const {}
    __device__ __forceinline__ void done(const Unit&) const {}
};

__device__ __forceinline__ unsigned cvt_pk_bf16(float lo, float hi) { unsigned r; asm volatile("v_cvt_pk_bf16_f32 %0, %1, %2" : "=v"(r) : "v"(lo), "v"(hi)); return r; }
typedef unsigned u32x2 __attribute__((ext_vector_type(2)));
struct OneUnit { int pm, pn;
    __device__ __forceinline__ bool next(int i, Unit& u) const { if (i) return false; u.pm = pm; u.pn = pn; return true; }
    __device__ __forceinline__ void a_ready(const Unit&) const {}
    __device__ __forceinline__ void done(const Unit&) const {} };

struct EpiInProj {
    static constexpr bool PERM = true, AFTER_DRAIN = false;
    bf16_t* gla; bf16_t* nq; bf16_t* kv; size_t kv_stride; float* rg; const float* tab;
    __device__ __forceinline__ void operator()(const f32x4 (&acc)[2][2][4][2], const Unit& u, int wr, int wc, int fr, int fq) const {
        const int pn = u.pn, row0 = u.pm * BM + wr * 64 + fr, c8 = wc * 32 + 8 * fq;
        if (pn < 6) {
#pragma unroll
            for (int ai = 0; ai < 2; ++ai)
#pragma unroll
                for (int m = 0; m < 4; ++m) { bf16_t* rowp = gla + (size_t)(row0 + ai * HALF + m * 16) * 1536 + pn * 256 + c8;
#pragma unroll
                    for (int bj = 0; bj < 2; ++bj) { const f32x4 v0 = acc[ai][bj][m][0], v1 = acc[ai][bj][m][1];
                        u32x4 w; w.x = cvt_pk_bf16(v0[0], v0[1]); w.y = cvt_pk_bf16(v0[2], v0[3]); w.z = cvt_pk_bf16(v1[0], v1[1]); w.w = cvt_pk_bf16(v1[2], v1[3]);
                        *(u32x4*)(rowp + bj * HALF) = w; } }
        } else if (pn == 14) {
            if (wc == 0) {
#pragma unroll
                for (int ai = 0; ai < 2; ++ai)
#pragma unroll
                    for (int m = 0; m < 4; ++m) { float* rp = rg + (size_t)(row0 + ai * HALF + m * 16) * 32 + 8 * fq;
                        *(f32x4*)rp = acc[ai][0][m][0]; *(f32x4*)(rp + 4) = acc[ai][0][m][1]; }
            }
        } else {
            const int b = (u.pm * BM) / SEQ, s0 = (u.pm * BM) % SEQ + wr * 64 + fr;
            bf16_t* T; int NH, hbase; bool rope;
            if (pn <= 7) { T = nq; NH = 4; hbase = 2 * (pn - 6); rope = true; }
            else { const int t = pn - 8; T = kv + (size_t)t * kv_stride; NH = 2; hbase = 0; rope = (t & 1) == 0; }
#pragma unroll
            for (int bj = 0; bj < 2; ++bj) { bf16_t* hb = T + (size_t)(b * NH + hbase + bj) * SEQ * 128;
#pragma unroll
                for (int ai = 0; ai < 2; ++ai)
#pragma unroll
                    for (int m = 0; m < 4; ++m) { const int s = s0 + ai * HALF + m * 16; const f32x4 v0 = acc[ai][bj][m][0], v1 = acc[ai][bj][m][1];
                        if (rope) { const int d0 = 16 * wc + 4 * fq; const f32x4* tp = (const f32x4*)(tab + ((size_t)(row0 + ai * HALF + m * 16) * 64 + d0) * 2);
                            const f32x4 ca = tp[0], cb = tp[1];
                            u32x2 w1, w2;
                            w1.x = cvt_pk_bf16(v0[0] * ca[0] - v1[0] * ca[1], v0[1] * ca[2] - v1[1] * ca[3]);
                            w1.y = cvt_pk_bf16(v0[2] * cb[0] - v1[2] * cb[1], v0[3] * cb[2] - v1[3] * cb[3]);
                            w2.x = cvt_pk_bf16(v1[0] * ca[0] + v0[0] * ca[1], v1[1] * ca[2] + v0[1] * ca[3]);
                            w2.y = cvt_pk_bf16(v1[2] * cb[0] + v0[2] * cb[1], v1[3] * cb[2] + v0[3] * cb[3]);
                            *(u32x2*)(hb + (size_t)s * 128 + d0) = w1; *(u32x2*)(hb + (size_t)s * 128 + 64 + d0) = w2;
                        } else { u32x4 w; w.x = cvt_pk_bf16(v0[0], v0[1]); w.y = cvt_pk_bf16(v0[2], v0[3]); w.z = cvt_pk_bf16(v1[0], v1[1]); w.w = cvt_pk_bf16(v1[2], v1[3]);
                            *(u32x4*)(hb + (size_t)s * 128 + c8) = w; } } }
        }
    }
};
template <int ACT> struct EpiActBf16 {
    static constexpr bool PERM = true, AFTER_DRAIN = false;
    bf16_t* O; int ldc; const float* bias;
    __device__ __forceinline__ float act(float x) const {
        if (ACT == 1) { const float u2 = 1.5957691216f * (x + 0.044715f * x * x * x); return x / (1.0f + __expf(-u2)); }
        else { const float r = fmaxf(x, 0.f); return r * r; } }
    __device__ __forceinline__ void operator()(const f32x4 (&acc)[2][2][4][2], const Unit& u, int wr, int wc, int fr, int fq) const {
        const int row0 = u.pm * BM + wr * 64 + fr, col0 = u.pn * BM + wc * 32 + 8 * fq;
        f32x4 bv[2][2];
#pragma unroll
        for (int bj = 0; bj < 2; ++bj)
#pragma unroll
            for (int n = 0; n < 2; ++n) bv[bj][n] = bias ? *(const f32x4*)(bias + col0 + bj * HALF + 4 * n) : (f32x4){0.f, 0.f, 0.f, 0.f};
#pragma unroll
        for (int ai = 0; ai < 2; ++ai)
#pragma unroll
            for (int m = 0; m < 4; ++m) { bf16_t* rowp = O + (size_t)(row0 + ai * HALF + m * 16) * ldc + col0;
#pragma unroll
                for (int bj = 0; bj < 2; ++bj) { const f32x4 v0 = acc[ai][bj][m][0] + bv[bj][0], v1 = acc[ai][bj][m][1] + bv[bj][1];
                    u32x4 w; w.x = cvt_pk_bf16(act(v0[0]), act(v0[1])); w.y = cvt_pk_bf16(act(v0[2]), act(v0[3])); w.z = cvt_pk_bf16(act(v1[0]), act(v1[1])); w.w = cvt_pk_bf16(act(v1[2]), act(v1[3]));
                    *(u32x4*)(rowp + bj * HALF) = w; } }
    }
};
struct EpiResid {
    static constexpr bool PERM = false, AFTER_DRAIN = false;
    const float* base; float* out; const float* gate;
    __device__ __forceinline__ void operator()(const f32x4 (&acc)[2][2][4][2], const Unit& u, int wr, int wc, int fr, int fq) const {
        const int row0 = u.pm * BM + wr * 64 + fr, col0 = u.pn * BM + wc * 32 + 4 * fq; const int b = (u.pm * BM) / SEQ;
        f32x4 gv[2][2];
#pragma unroll
        for (int bj = 0; bj < 2; ++bj)
#pragma unroll
            for (int n = 0; n < 2; ++n) gv[bj][n] = *(const f32x4*)(gate + (size_t)b * NMOD + col0 + bj * HALF + n * 16);
#pragma unroll
        for (int ai = 0; ai < 2; ++ai)
#pragma unroll
            for (int m = 0; m < 4; ++m) { const size_t off = (size_t)(row0 + ai * HALF + m * 16) * DM + col0;
#pragma unroll
                for (int bj = 0; bj < 2; ++bj)
#pragma unroll
                    for (int n = 0; n < 2; ++n) { const f32x4 bs = *(const f32x4*)(base + off + bj * HALF + n * 16);
                        *(f32x4*)(out + off + bj * HALF + n * 16) = bs + gv[bj][n] * acc[ai][bj][m][n]; } }
    }
};
template <class Epi, class Sched, bool ALIGN_EPI = false, bool SP2 = false>
__device__ __forceinline__ void gemm_phase(PG8_LAS unsigned char* lds, const Gemm g, const Sched& S, const Epi& E) {
    int tid = threadIdx.x; asm volatile("" : "+v"(tid)); const int wid = __builtin_amdgcn_readfirstlane(tid >> 6), lane = tid & 63, wr = wid >> 2, wc = wid & 3, fr = lane & 15, fq = lane >> 4;
    const int K = g.K, nt = K / BK;
    unsigned voffA[2], voffB[2];
#pragma unroll
    for (int i = 0; i < 2; ++i) { int R, C; stage_rc(tid * 16 + i * 8192, R, C); const int Rb = Epi::PERM ? ((R & ~31) + perm32(R & 31)) : R;
        voffA[i] = (unsigned)(R * g.lda + C) * 2u; voffB[i] = (unsigned)(Rb * K + C) * 2u; }
    const size_t kstep = (size_t)(BK * 2);
    const size_t hstepB = (size_t)HALF * K * 2, hstepA = (size_t)HALF * g.lda * 2;
    const size_t tstepB = 2 * hstepB, tstepA = 2 * hstepA;
    const unsigned ldsw = (unsigned)wid * 1024u;
    const int aoff = lds_byte(wr * 64 + fr, fq * 8), boff = lds_byte(wc * 32 + fr, fq * 8);
#define PG8_SA(b, h) (((b) * 2 + (h)) * HTB)
#define PG8_SB(b, h) ((4 + (b) * 2 + (h)) * HTB)
#define PG8_STAGE(bufoff, gbase, voff) do { _Pragma("unroll") for (int _i = 0; _i < 2; ++_i) \
        __builtin_amdgcn_global_load_lds((const unsigned*)((const char*)(gbase) + (voff)[_i]), (PG8_LAS unsigned*)(lds + (bufoff) + ldsw + _i * 8192), 16, 0, 0); } while (0)
#define PG8_LDA(dst, b, h) do { _Pragma("unroll") for (int m = 0; m < 4; ++m) _Pragma("unroll") for (int k = 0; k < 2; ++k) dst[m][k] = *(const PG8_LAS bf16x8*)(lds + PG8_SA(b, h) + aoff + m * 2048 + k * 1024); } while (0)
#define PG8_LDB(dst, b, h) do { _Pragma("unroll") for (int n = 0; n < 2; ++n) _Pragma("unroll") for (int k = 0; k < 2; ++k) dst[n][k] = *(const PG8_LAS bf16x8*)(lds + PG8_SB(b, h) + boff + n * 2048 + k * 1024); } while (0)
#define PG8_MMA(ai, bj, At, Bt) do { __builtin_amdgcn_s_setprio(1); _Pragma("unroll") for (int m = 0; m < 4; ++m) _Pragma("unroll") for (int n = 0; n < 2; ++n) _Pragma("unroll") for (int k = 0; k < 2; ++k) \
        acc[ai][bj][m][n] = __builtin_amdgcn_mfma_f32_16x16x32_bf16(Bt[n][k], At[m][k], acc[ai][bj][m][n], 0, 0, 0); __builtin_amdgcn_s_setprio(0); } while (0)
#define PG8_WAIT_V(n) asm volatile("s_waitcnt vmcnt(" #n ")" ::: "memory")
#define PG8_WAIT_L(n) asm volatile("s_waitcnt lgkmcnt(" #n ")" ::: "memory")
#define PG8_BAR __builtin_amdgcn_s_barrier()
#define PG8_SCHED __builtin_amdgcn_sched_barrier(0)
    Unit cur, nxt; int ui = 0;
    if (!S.next(0, cur)) return;
    f32x4 acc[2][2][4][2];
#pragma unroll
    for (int a = 0; a < 2; ++a)
#pragma unroll
        for (int b = 0; b < 2; ++b)
#pragma unroll
            for (int m = 0; m < 4; ++m)
#pragma unroll
                for (int n = 0; n < 2; ++n) acc[a][b][m][n] = (f32x4){0.f, 0.f, 0.f, 0.f};
    bf16x8 At[4][2], B0[2][2], B1[2][2];
    const char* cA = (const char*)g.A + (size_t)cur.pm * tstepA; const char* cB = (const char*)g.Bt + (size_t)cur.pn * tstepB;
    S.a_ready(cur);
    if constexpr (SP2) {
        PG8_STAGE(PG8_SB(0, 0), cB, voffB); PG8_STAGE(PG8_SB(0, 1), cB + hstepB, voffB); PG8_STAGE(PG8_SA(0, 0), cA, voffA); PG8_STAGE(PG8_SA(0, 1), cA + hstepA, voffA);
        if (wr == 1) PG8_BAR;
        PG8_WAIT_V(2); PG8_BAR;
        PG8_STAGE(PG8_SB(1, 0), cB + kstep, voffB); PG8_STAGE(PG8_SA(1, 0), cA + kstep, voffA); PG8_STAGE(PG8_SB(1, 1), cB + hstepB + kstep, voffB);
        PG8_WAIT_V(6); PG8_BAR;
    } else {
        PG8_STAGE(PG8_SB(0, 0), cB, voffB); PG8_STAGE(PG8_SA(0, 0), cA, voffA); PG8_STAGE(PG8_SB(0, 1), cB + hstepB, voffB); PG8_STAGE(PG8_SA(0, 1), cA + hstepA, voffA);
        if (wr == 1) PG8_BAR;
        PG8_WAIT_V(4); PG8_BAR;
        PG8_STAGE(PG8_SB(1, 0), cB + kstep, voffB); PG8_STAGE(PG8_SA(1, 0), cA + kstep, voffA); PG8_STAGE(PG8_SB(1, 1), cB + hstepB + kstep, voffB);
        PG8_WAIT_V(6); PG8_BAR;
    }
    for (;;) {
        const bool has_next = S.next(ui + 1, nxt);
        const char* nA = has_next ? (const char*)g.A + (size_t)nxt.pm * tstepA : cA; const char* nB = has_next ? (const char*)g.Bt + (size_t)nxt.pn * tstepB : cB;
        for (int t = 0; t < nt; t += 2) {
            const bool last = (t == nt - 2);
            const char* a1 = cA + (size_t)(t + 1) * kstep;
            const char* a2 = last ? nA : cA + (size_t)(t + 2) * kstep; const char* b2 = last ? nB : cB + (size_t)(t + 2) * kstep;
            const char* a3 = a2 + kstep; const char* b3 = b2 + kstep;
            if (last && has_next) S.a_ready(nxt);
            if constexpr (SP2) {
            PG8_LDB(B0, 0, 0); PG8_LDB(B1, 0, 1); PG8_SCHED; PG8_LDA(At, 0, 0); PG8_STAGE(PG8_SA(1, 1), a1 + hstepA, voffA);
            PG8_WAIT_V(8); PG8_WAIT_L(0); PG8_BAR; PG8_MMA(0, 0, At, B0); PG8_MMA(0, 1, At, B1); PG8_BAR; PG8_SCHED;
            PG8_LDA(At, 0, 1); PG8_STAGE(PG8_SB(0, 0), b2, voffB); PG8_STAGE(PG8_SB(0, 1), b2 + hstepB, voffB); PG8_STAGE(PG8_SA(0, 0), a2, voffA);
            PG8_WAIT_V(8); PG8_WAIT_L(0); PG8_BAR; PG8_MMA(1, 0, At, B0); PG8_MMA(1, 1, At, B1); PG8_BAR; PG8_SCHED;
            PG8_LDB(B0, 1, 0); PG8_LDB(B1, 1, 1); PG8_SCHED; PG8_LDA(At, 1, 0); PG8_STAGE(PG8_SA(0, 1), a2 + hstepA, voffA);
            PG8_WAIT_V(8); PG8_WAIT_L(0); PG8_BAR; PG8_MMA(0, 0, At, B0); PG8_MMA(0, 1, At, B1); PG8_BAR; PG8_SCHED;
            PG8_LDA(At, 1, 1); PG8_STAGE(PG8_SB(1, 0), b3, voffB); PG8_STAGE(PG8_SB(1, 1), b3 + hstepB, voffB); PG8_STAGE(PG8_SA(1, 0), a3, voffA);
            PG8_WAIT_V(8); PG8_WAIT_L(0); PG8_BAR; PG8_MMA(1, 0, At, B0); PG8_MMA(1, 1, At, B1); PG8_BAR; PG8_SCHED;
            } else {
            PG8_LDB(B0, 0, 0); PG8_SCHED; PG8_LDA(At, 0, 0); PG8_STAGE(PG8_SA(1, 1), a1 + hstepA, voffA);
            PG8_WAIT_L(8); PG8_BAR; PG8_WAIT_L(0); PG8_MMA(0, 0, At, B0); PG8_BAR; PG8_SCHED;
            PG8_LDB(B1, 0, 1); PG8_STAGE(PG8_SB(0, 0), b2, voffB);
            PG8_BAR; PG8_WAIT_L(0); PG8_MMA(0, 1, At, B1); PG8_BAR;
            PG8_LDA(At, 0, 1); PG8_STAGE(PG8_SA(0, 0), a2, voffA);
            PG8_BAR; PG8_WAIT_L(0); PG8_MMA(1, 0, At, B0); PG8_BAR; PG8_SCHED;
            PG8_STAGE(PG8_SB(0, 1), b2 + hstepB, voffB);
            PG8_WAIT_V(6); PG8_BAR; PG8_MMA(1, 1, At, B1); PG8_BAR;
            PG8_LDB(B0, 1, 0); PG8_SCHED; PG8_LDA(At, 1, 0); PG8_STAGE(PG8_SA(0, 1), a2 + hstepA, voffA);
            PG8_WAIT_L(8); PG8_BAR; PG8_WAIT_L(0); PG8_MMA(0, 0, At, B0); PG8_BAR; PG8_SCHED;
            PG8_LDB(B1, 1, 1); PG8_STAGE(PG8_SB(1, 0), b3, voffB);
            PG8_BAR; PG8_WAIT_L(0); PG8_MMA(0, 1, At, B1); PG8_BAR;
            PG8_LDA(At, 1, 1); PG8_STAGE(PG8_SA(1, 0), a3, voffA);
            PG8_BAR; PG8_WAIT_L(0); PG8_MMA(1, 0, At, B0); PG8_BAR; PG8_SCHED;
            PG8_STAGE(PG8_SB(1, 1), b3 + hstepB, voffB);
            PG8_WAIT_V(6); PG8_BAR; PG8_MMA(1, 1, At, B1); PG8_BAR;
            }
        }
        if constexpr (ALIGN_EPI) { if (wr == 0) PG8_BAR; }
        if constexpr (!Epi::AFTER_DRAIN) { E(acc, cur, wr, wc, fr, fq); S.done(cur); }
        if (!has_next) break;
#pragma unroll
        for (int a = 0; a < 2; ++a)
#pragma unroll
            for (int b = 0; b < 2; ++b)
#pragma unroll
                for (int m = 0; m < 4; ++m)
#pragma unroll
                    for (int n = 0; n < 2; ++n) acc[a][b][m][n] = (f32x4){0.f, 0.f, 0.f, 0.f};
        cur = nxt; cA = nA; cB = nB; ++ui;
        if constexpr (ALIGN_EPI) { if (wr == 1) PG8_BAR; }
    }
    PG8_WAIT_V(0);
    if constexpr (!ALIGN_EPI) { if (wr == 0) PG8_BAR; }
    PG8_BAR;
    if constexpr (Epi::AFTER_DRAIN) { E.fused(acc, cur, wr, wc, fr, fq, lds, wid, lane); S.done(cur); }
#undef PG8_SA
#undef PG8_SB
#undef PG8_STAGE
#undef PG8_LDA
#undef PG8_LDB
#undef PG8_MMA
#undef PG8_WAIT_V
#undef PG8_WAIT_L
#undef PG8_BAR
#undef PG8_SCHED
}
}
namespace nsa {
typedef unsigned short bf16_t;
typedef short bf16x8 __attribute__((ext_vector_type(8)));
typedef short s16x4 __attribute__((ext_vector_type(4)));
typedef float f32x16 __attribute__((ext_vector_type(16)));
typedef float f32x4 __attribute__((ext_vector_type(4)));
typedef unsigned u32x4 __attribute__((ext_vector_type(4)));
constexpr int D = 128, KVBLK = 64, QBLK = 32, UROWS = 128;
constexpr float SCALE = 0.08838834764831845f;
constexpr int SHM_V = KVBLK * D * 2, SHM_K = KVBLK * D * 2;
constexpr int L_V = 0, L_K = 2 * SHM_V, L_WS = 2 * SHM_V + 2 * SHM_K, L_IMP = L_WS + 8 * 64 * 4, L_QF = L_IMP  , L_SELB = L_IMP + 2 * UROWS * 32 * 4, L_END = L_QF + 8 * 8192;
#define KSWZ(row, colB) ((row) * 256 + ((colB) ^ (((row) & 7) << 4)))
#define SBAR() __builtin_amdgcn_sched_barrier(0)
__device__ __forceinline__ int v_st(int k, int c) { const int kk = (k & ~0xC) | ((k & 4) << 1) | ((k & 8) >> 1); return ((kk >> 3) * 4 + (c >> 5)) * 512 + ((kk & 7) * 32 + (c & 31)) * 2; }
__device__ __forceinline__ int v_rd_base(int lane) { return ((lane & 3) << 3) | (((lane >> 2) & 3) << 6) | (((lane >> 4) & 1) << 5) | (((lane >> 5) & 1) << 8); }
constexpr int v_rd_off(int d0, int ks, int half) { return d0 * 512 + ks * 4096 + half * 2048; }
__device__ __forceinline__ int crow(int r, int hi) { return (r & 3) + 8 * (r >> 2) + 4 * hi; }
__device__ __forceinline__ unsigned cvtpk(float lo, float hi) { unsigned r; asm volatile("v_cvt_pk_bf16_f32 %0, %1, %2" : "=v"(r) : "v"(lo), "v"(hi)); return r; }
__device__ __forceinline__ void mask_tile(f32x16& p0, f32x16& p1, int dq, unsigned W) {
    const float NEG = -__builtin_inff();
#pragma unroll
    for (int r = 0; r < 16; ++r) { const int c = (r & 3) + 8 * (r >> 2);
        if ((unsigned)(dq - c) >= W) p0[r] = NEG;
        if ((unsigned)(dq - c - 32) >= W) p1[r] = NEG; }
}
__device__ __forceinline__ void partialSM(f32x16& p0, f32x16& p1, float& m_reg, float& mn, float& alpha) {
    float pmax = p0[0];
#pragma unroll
    for (int r = 1; r < 16; ++r) pmax = fmaxf(pmax, p0[r]);
#pragma unroll
    for (int r = 0; r < 16; ++r) pmax = fmaxf(pmax, p1[r]);
    { auto rr = __builtin_amdgcn_permlane32_swap(__float_as_uint(pmax), __float_as_uint(pmax), false, false);
      pmax = fmaxf(__uint_as_float(rr[0]), __uint_as_float(rr[1])); }
    constexpr float C2 = 1.4426950408889634f * SCALE;
    if (__builtin_expect(__all(pmax <= m_reg), 0)) { mn = m_reg; alpha = 1.f; }
    else { mn = fmaxf(m_reg, pmax); alpha = __builtin_amdgcn_exp2f((m_reg - mn) * C2); m_reg = mn; }
    const float mnL = -mn * C2;
#pragma unroll
    for (int r = 0; r < 16; ++r) p0[r] = fmaf(p0[r], C2, mnL);
#pragma unroll
    for (int r = 0; r < 16; ++r) p1[r] = fmaf(p1[r], C2, mnL);
#pragma unroll
    for (int r = 0; r < 16; ++r) p0[r] = __builtin_amdgcn_exp2f(p0[r]);
}
#define PK4(P, B_, OUT) do { unsigned a0 = cvtpk(P[B_+0], P[B_+1]), a1 = cvtpk(P[B_+2], P[B_+3]);                          \
        unsigned b0 = cvtpk(P[B_+4], P[B_+5]), b1 = cvtpk(P[B_+6], P[B_+7]);                                             \
        auto r0 = __builtin_amdgcn_permlane32_swap(a0, b0, false, false); auto r1 = __builtin_amdgcn_permlane32_swap(a1, b1, false, false); \
        u32x4 w = {r0[0], r1[0], r0[1], r1[1]}; OUT = *reinterpret_cast<bf16x8*>(&w); } while (0)
__device__ __forceinline__ void finishSM(f32x16& p0, f32x16& p1, float alpha, float& l_reg, bf16x8& pa0, bf16x8& pa1, bf16x8& pa2, bf16x8& pa3) {
#pragma unroll
    for (int r = 0; r < 16; ++r) p1[r] = __builtin_amdgcn_exp2f(p1[r]);
    float ps = 0;
#pragma unroll
    for (int r = 0; r < 16; ++r) ps += p0[r];
#pragma unroll
    for (int r = 0; r < 16; ++r) ps += p1[r];
    { auto rr = __builtin_amdgcn_permlane32_swap(__float_as_uint(ps), __float_as_uint(ps), false, false);
      ps = __uint_as_float(rr[0]) + __uint_as_float(rr[1]); }
    l_reg = l_reg * alpha + ps;
    PK4(p0, 0, pa0); PK4(p0, 8, pa1); PK4(p1, 0, pa2); PK4(p1, 8, pa3);
}
template <int KB>
__device__ __forceinline__ void qkt(f32x16& p0, f32x16& p1, const char* K_lds, int r32, int hi, const bf16x8* qr) {
    p0 = f32x16{}; p1 = f32x16{};
    const char* kb[4];
#pragma unroll
    for (int dd = 0; dd < 4; ++dd) kb[dd] = K_lds + KB * SHM_K + KSWZ(r32, (dd * 16 + hi * 8) * 2);
#pragma unroll
    for (int d0 = 0; d0 < 8; ++d0) { const char* a = kb[d0 & 3] + (d0 >> 2) * 128;
        bf16x8 b0 = *reinterpret_cast<const bf16x8*>(a);
        bf16x8 b1 = *reinterpret_cast<const bf16x8*>(a + 32 * 256);
        p0 = __builtin_amdgcn_mfma_f32_32x32x16_bf16(b0, qr[d0], p0, 0, 0, 0);
        p1 = __builtin_amdgcn_mfma_f32_32x32x16_bf16(b1, qr[d0], p1, 0, 0, 0); }
}
template <int KB>
__device__ __forceinline__ void qkt2(f32x16& p0, f32x16& p1, const char* K_lds, int r32, int hi, const char* qf) {
    p0 = f32x16{}; p1 = f32x16{};
    const char* kb[4];
#pragma unroll
    for (int dd = 0; dd < 4; ++dd) kb[dd] = K_lds + KB * SHM_K + KSWZ(r32, (dd * 16 + hi * 8) * 2);
#pragma unroll
    for (int d0 = 0; d0 < 8; ++d0) { const char* a = kb[d0 & 3] + (d0 >> 2) * 128;
        bf16x8 b0 = *reinterpret_cast<const bf16x8*>(a);
        bf16x8 b1 = *reinterpret_cast<const bf16x8*>(a + 32 * 256);
        const bf16x8 q = *reinterpret_cast<const bf16x8*>(qf + d0 * 1024);
        p0 = __builtin_amdgcn_mfma_f32_32x32x16_bf16(b0, q, p0, 0, 0, 0);
        p1 = __builtin_amdgcn_mfma_f32_32x32x16_bf16(b1, q, p1, 0, 0, 0); }
}
template <int VB>
__device__ __forceinline__ void pv_tile(f32x16* o, int vb0, bf16x8 pa0, bf16x8 pa1, bf16x8 pa2, bf16x8 pa3) {
#define TRRD(dst, off) asm volatile("ds_read_b64_tr_b16 %0, %1 offset:%2" : "=&v"(dst) : "v"(vb0), "i"(off) : "memory")
#define PV_D0(d0) do { s16x4 l0, l1, l2, l3, h0, h1, h2, h3; constexpr int b_ = VB * SHM_V + v_rd_off(d0, 0, 0); \
        TRRD(l0, b_); TRRD(h0, b_ + 2048); TRRD(l1, b_ + 4096); TRRD(h1, b_ + 6144); TRRD(l2, b_ + 8192); TRRD(h2, b_ + 10240); TRRD(l3, b_ + 12288); TRRD(h3, b_ + 14336); \
        asm volatile("s_waitcnt lgkmcnt(0)" ::: "memory"); SBAR();   \
        o[d0] = __builtin_amdgcn_mfma_f32_32x32x16_bf16(pa0, (bf16x8){l0[0], l0[1], l0[2], l0[3], h0[0], h0[1], h0[2], h0[3]}, o[d0], 0, 0, 0);   \
        o[d0] = __builtin_amdgcn_mfma_f32_32x32x16_bf16(pa1, (bf16x8){l1[0], l1[1], l1[2], l1[3], h1[0], h1[1], h1[2], h1[3]}, o[d0], 0, 0, 0);   \
        o[d0] = __builtin_amdgcn_mfma_f32_32x32x16_bf16(pa2, (bf16x8){l2[0], l2[1], l2[2], l2[3], h2[0], h2[1], h2[2], h2[3]}, o[d0], 0, 0, 0);   \
        o[d0] = __builtin_amdgcn_mfma_f32_32x32x16_bf16(pa3, (bf16x8){l3[0], l3[1], l3[2], l3[3], h3[0], h3[1], h3[2], h3[3]}, o[d0], 0, 0, 0); } while (0)
    PV_D0(0); PV_D0(1); PV_D0(2); PV_D0(3);
#undef PV_D0
#undef TRRD
}
__device__ __forceinline__ int swa_jlo(int P0, int W) { const int lowk = P0 - W + 1; return lowk > 0 ? lowk / KVBLK : 0; }
#define ROW(p, k0, rr) ((p) + (size_t)((k0) + (rr)) * D + sc)
#define VMW() asm volatile("s_waitcnt vmcnt(0)" ::: "memory")
#define SLOAD_H(Kp, Vp, k0) do { st_v0 = *(const bf16x8*)ROW(Vp, k0, sr); st_v1 = *(const bf16x8*)ROW(Vp, k0, 32 + sr); \
                                 st_k0 = *(const bf16x8*)ROW(Kp, k0, sr); st_k1 = *(const bf16x8*)ROW(Kp, k0, 32 + sr); } while (0)
#define SWRITE_HK(bf) do { *(bf16x8*)(K_lds + (bf) * SHM_K + kws) = st_k0; *(bf16x8*)(K_lds + (bf) * SHM_K + kws + 32 * 256) = st_k1; } while (0)
#define SWRITE_HV(bf) do { *(bf16x8*)(V_lds + (bf) * SHM_V + vst0) = st_v0; *(bf16x8*)(V_lds + (bf) * SHM_V + vst1) = st_v1; } while (0)
#define SWRITE_H(bf) do { SWRITE_HV(bf); SWRITE_HK(bf); } while (0)
#define STORE_O() do { int t3_ = threadIdx.x; asm volatile("" : "+v"(t3_)); float* li_l = (float*)(lds + L_WS) + (t3_ >> 6) * 64;                   \
        if (hi == 0) li_l[r32] = l_inv; asm volatile("s_waitcnt lgkmcnt(0)" ::: "memory"); float rli[16];                       \
        __attribute__((address_space(1))) bf16_t* Ob_ = (__attribute__((address_space(1))) bf16_t*)Ow; asm volatile("" : "+v"(Ob_));           \
        _Pragma("unroll") for (int r = 0; r < 16; ++r) rli[r] = li_l[crow(r, hi)];                                                         \
        _Pragma("unroll") for (int r = 0; r < 16; ++r) { const int orow = crow(r, hi);                                                     \
            _Pragma("unroll") for (int d0 = 0; d0 < 4; ++d0) { const float v = o[d0][r] * rli[r]; const float vn = __shfl_xor(v, 1);       \
                if ((r32 & 1) == 0) *(__attribute__((address_space(1))) unsigned*)(Ob_ + (size_t)orow * opitch + d0 * 32 + r32) = cvtpk(v, vn); } } } while (0)

template <bool SEL>
__device__ __forceinline__ void attn_branch(const bf16_t* Qw, const bf16_t* Kh, const bf16_t* Vh, bf16_t* Ow, int opitch, int P0, int qrel, int W, const unsigned* selg, char* lds) {
    int tid = threadIdx.x; asm volatile("" : "+v"(tid));
    const int lane = tid & 63, r32 = lane & 31, hi = lane >> 5;
    const int j_lo = SEL ? 0 : swa_jlo(P0, W);
    const int j_hi = (P0 + UROWS - 1) / KVBLK + 1;
    const int NT = j_hi - j_lo;
    const int qlo = P0 + qrel, qm = qlo + r32 - 4 * hi;
    char* V_lds = lds + L_V; char* K_lds = lds + L_K;
    unsigned selbits = 0xffffffffu; if (SEL) selbits = selg[qrel + r32];
    float m_reg = -1e30f, l_reg = 0; f32x16 o[4] = {};
    const int sr = tid >> 4, sc = (tid & 15) * 8, vst0 = v_st(sr, sc), vst1 = v_st(32 + sr, sc), kws = KSWZ(sr, sc * 2);
    const int vb0 = (int)(uintptr_t)V_lds + v_rd_base(lane);
    char* qf = lds + L_QF + (tid >> 6) * 8192 + lane * 16;
#pragma unroll
    for (int d0 = 0; d0 < 8; ++d0) *(bf16x8*)(qf + d0 * 1024) = *(const bf16x8*)(Qw + (size_t)r32 * D + d0 * 16 + hi * 8);
    bf16x8 st_v0, st_v1, st_k0, st_k1;
#define RESC(a) do { if (__any((a) < 1.f)) { int t2_ = threadIdx.x; asm volatile("" : "+v"(t2_));     \
                     float* al2_ = (float*)(lds + L_WS) + (t2_ >> 6) * 64 + 32; const int h2_ = (t2_ >> 5) & 1;                                    \
                     if (h2_ == 0) al2_[t2_ & 31] = (a); asm volatile("s_waitcnt lgkmcnt(0)" ::: "memory");              \
                     _Pragma("unroll") for (int d_ = 0; d_ < 4; ++d_) _Pragma("unroll") for (int r = 0; r < 16; ++r) o[d_][r] *= al2_[crow(r, h2_)]; } } while (0)
#define KBASE(t) ((j_lo + (t)) * KVBLK)
#define MASKT(P0_, P1_, t) do { const int kb_ = KBASE(t); if (kb_ + KVBLK - 1 > qlo || kb_ <= qlo + QBLK - 1 - W) mask_tile(P0_, P1_, qm - kb_, (unsigned)W);  \
        if (SEL) { const bool off_ = ((selbits >> (j_lo + (t))) & 1u) == 0u; const float NEG_ = -__builtin_inff();                                          \
            _Pragma("unroll") for (int r = 0; r < 16; ++r) { P0_[r] = off_ ? NEG_ : P0_[r]; P1_[r] = off_ ? NEG_ : P1_[r]; } } } while (0)
    f32x16 p0, p1; float mn, al; bf16x8 pa0, pa1, pa2, pa3;
    SLOAD_H(Kh, Vh, KBASE(0)); VMW(); SWRITE_H(0);
    if (NT > 1) SLOAD_H(Kh, Vh, KBASE(1));
    __syncthreads();
    for (int t = 0; t < NT; ++t) { const int bo = t & 1;
        SBAR(); qkt2<0>(p0, p1, K_lds + bo * SHM_K, r32, hi, qf);
        MASKT(p0, p1, t); partialSM(p0, p1, m_reg, mn, al); RESC(al);
        finishSM(p0, p1, al, l_reg, pa0, pa1, pa2, pa3); SBAR();
        pv_tile<0>(o, vb0 + bo * SHM_V, pa0, pa1, pa2, pa3); SBAR();
        if (t + 1 < NT) { VMW(); SWRITE_H(bo ^ 1); if (t + 2 < NT) SLOAD_H(Kh, Vh, KBASE(t + 2)); }
        __syncthreads(); }
    const float l_inv = __builtin_amdgcn_rcpf(l_reg);
    STORE_O();
    __syncthreads();
#undef RESC
#undef KBASE
#undef MASKT
#undef HALF_STEP
}

__device__ __forceinline__ void cmp_branch(const bf16_t* Qw, const bf16_t* Kc, const bf16_t* Vc, bf16_t* Ow, int opitch, int P0, int qrel, int g, unsigned* selg, char* lds) {
    int tid = threadIdx.x; asm volatile("" : "+v"(tid));
    const int lane = tid & 63, r32 = lane & 31, hi = lane >> 5;
    char* V_lds = lds + L_V; char* K_lds = lds + L_K;
    float* imp = (float*)(lds + L_IMP); unsigned* selb = (unsigned*)(lds + L_SELB);
    const int sr = tid >> 4, sc = (tid & 15) * 8, vst0 = v_st(sr, sc), vst1 = v_st(32 + sr, sc), kws = KSWZ(sr, sc * 2);
    const int vb0 = (int)(uintptr_t)V_lds + v_rd_base(lane);
    bf16x8 qr[8];
#pragma unroll
    for (int d0 = 0; d0 < 8; ++d0) qr[d0] = *(const bf16x8*)(Qw + (size_t)r32 * D + d0 * 16 + hi * 8);
    bf16x8 st_v0, st_v1, st_k0, st_k1;
    SLOAD_H(Kc, Vc, 0); VMW(); SWRITE_H(0); SBAR();
    SLOAD_H(Kc, Vc, 64); VMW(); SWRITE_H(1);
    __syncthreads();
    f32x16 pA0, pA1, pB0, pB1;
    qkt<0>(pA0, pA1, K_lds, r32, hi, qr); SBAR(); qkt<1>(pB0, pB1, K_lds, r32, hi, qr); SBAR();
    const int tpos = P0 + qrel + r32, nmax = (tpos - 31) >> 4;
    const float NEG = -__builtin_inff();
    const int nm = nmax - 4 * hi;
#pragma unroll
    for (int r = 0; r < 16; ++r) { const int c = (r & 3) + 8 * (r >> 2);
        if (c > nm) pA0[r] = NEG; if (c + 32 > nm) pA1[r] = NEG; if (c + 64 > nm) pB0[r] = NEG; if (c + 96 > nm) pB1[r] = NEG; }
    float pmax = NEG;
#pragma unroll
    for (int r = 0; r < 16; ++r) pmax = fmaxf(fmaxf(pmax, pA0[r]), fmaxf(pA1[r], fmaxf(pB0[r], pB1[r])));
    { auto rr = __builtin_amdgcn_permlane32_swap(__float_as_uint(pmax), __float_as_uint(pmax), false, false);
      pmax = fmaxf(__uint_as_float(rr[0]), __uint_as_float(rr[1])); }
    constexpr float C2 = 1.4426950408889634f * SCALE;
    const float mnL = -fmaxf(pmax, -1e30f) * C2;
    float ps = 0.f;
#pragma unroll
    for (int r = 0; r < 16; ++r) { pA0[r] = __builtin_amdgcn_exp2f(fmaf(pA0[r], C2, mnL)); pA1[r] = __builtin_amdgcn_exp2f(fmaf(pA1[r], C2, mnL));
        pB0[r] = __builtin_amdgcn_exp2f(fmaf(pB0[r], C2, mnL)); pB1[r] = __builtin_amdgcn_exp2f(fmaf(pB1[r], C2, mnL));
        ps += (pA0[r] + pA1[r]) + (pB0[r] + pB1[r]); }
    { auto rr = __builtin_amdgcn_permlane32_swap(__float_as_uint(ps), __float_as_uint(ps), false, false);
      ps = __uint_as_float(rr[0]) + __uint_as_float(rr[1]); }
    const float l_inv = ps > 0.f ? 1.0f / ps : 0.f; SBAR();
#if !defined(CMP_NO_IMP)
    { float A[16], Bo[16], Bp[16];
#define IMPG(P, T) _Pragma("unroll") for (int rq = 0; rq < 4; ++rq) { const float h3 = 0.5f * P[4 * rq + 3]; A[(T) * 4 + rq] = (P[4 * rq] + P[4 * rq + 1]) + (P[4 * rq + 2] + h3); Bo[(T) * 4 + rq] = h3; }
      IMPG(pA0, 0) IMPG(pA1, 1) IMPG(pB0, 2) IMPG(pB1, 3)
#undef IMPG
#pragma unroll
      for (int i = 0; i < 16; ++i) Bp[i] = __shfl_xor(Bo[i], 32);
      float* dst = imp + ((size_t)g * UROWS + qrel + r32) * 32 + hi;
#pragma unroll
      for (int i = 0; i < 16; ++i) { const float prev = i > 0 ? Bp[i - 1] : 0.f; const float v = (A[i] + (hi ? Bp[i] : prev)) * l_inv; dst[2 * i] = v; } }
#endif
    SBAR(); bf16x8 pa0, pa1, pa2, pa3; f32x16 o[4] = {};
#if !defined(CMP_NO_PV)
    PK4(pA0, 0, pa0); PK4(pA0, 8, pa1); PK4(pA1, 0, pa2); PK4(pA1, 8, pa3); SBAR();
    pv_tile<0>(o, vb0, pa0, pa1, pa2, pa3);
    PK4(pB0, 0, pa0); PK4(pB0, 8, pa1); PK4(pB1, 0, pa2); PK4(pB1, 8, pa3); SBAR();
    pv_tile<1>(o, vb0, pa0, pa1, pa2, pa3); SBAR();
#endif
    STORE_O(); SBAR();
    __syncthreads();
#if !defined(CMP_NO_TOPK)
    { const int token = tid >> 2, sub = tid & 3; const float* i0 = imp + (size_t)token * 32; const float* i1 = imp + (size_t)(UROWS + token) * 32;
      const int bt = (P0 + token) >> 6; float v[32];
#pragma unroll
      for (int i = 0; i < 32; ++i) { const float x = i0[i] + i1[i]; const bool forced = (i == 0) || (i == bt) || (i == bt - 1); v[i] = forced ? 1e30f : (i <= bt ? x : -1e30f); }
      unsigned bits = 0u;
#pragma unroll
      for (int jj = 0; jj < 8; ++jj) { const int j = 4 * jj + sub; const float xj = i0[j] + i1[j]; const bool forced = (j == 0) || (j == bt) || (j == bt - 1);
          const float vj = forced ? 1e30f : (j <= bt ? xj : -1e30f); int cnt = 0;
#pragma unroll
          for (int i = 0; i < 32; ++i) { bool c;
              if ((i >> 2) < jj) c = v[i] >= vj; else if ((i >> 2) > jj) c = v[i] > vj; else c = ((i & 3) < sub) ? (v[i] >= vj) : (v[i] > vj);
              cnt += c ? 1 : 0; }
          if (cnt < 16) bits |= 1u << j;
          SBAR(); }
      bits |= __shfl_xor(bits, 1); bits |= __shfl_xor(bits, 2);
      if (sub == 0) { selb[token] = bits; if (selg) selg[token] = bits; } }
#endif
    asm volatile("s_waitcnt vmcnt(0)" ::: "memory");
    __syncthreads();
}
#undef ROW
#undef SLOAD_H
#undef SWRITE_HK
#undef SWRITE_HV
#undef SWRITE_H
#undef STORE_O
#undef PK4
#undef VMW
#undef SBAR
#undef KSWZ
}
constexpr int NWAVES = 8;
#ifndef MK_N_LAUNCHES
#define MK_N_LAUNCHES 1
#endif
constexpr int N_PHASES = 12;
constexpr int N_LAUNCHES = MK_N_LAUNCHES;
constexpr size_t MiB = 1u << 20;
constexpr size_t WS_CTL = 0, CTL_ZERO_BYTES = 1 * MiB;
constexpr size_t WS_MOD = 256 * 1024;
constexpr size_t WS_PEB = 704 * 1024;
constexpr size_t WS_WIN = 2 * MiB, WS_WO = 10 * MiB, WS_WFF1 = 12 * MiB, WS_WFF2 = 20 * MiB, WS_CKW1 = 28 * MiB, WS_CVW1 = 30 * MiB;
constexpr size_t WS_TAB = 32 * MiB;
constexpr size_t WS_XN = 48 * MiB;
constexpr size_t WS_RG = 112 * MiB;
constexpr size_t WS_HID = 116 * MiB;
constexpr size_t WS_KCMP = 120 * MiB, WS_VCMP = 121 * MiB;
constexpr size_t WS_SEL = 122 * MiB;
constexpr size_t WS_H = 124 * MiB;
constexpr size_t WS_GLA = 124 * MiB;
constexpr size_t WS_NQ = 220 * MiB;
constexpr size_t WS_KV = 252 * MiB, KV_STRIDE_B = 17 * MiB;
constexpr size_t WS_OBR = 380 * MiB, OBR_STRIDE_B = 32 * MiB;
constexpr size_t WS_END = 476 * MiB;
static_assert(WS_KV + 6 * KV_STRIDE_B <= WS_OBR && WS_H + (size_t)MTOK * DFF * 2 <= WS_OBR && WS_MOD + 16 * NMOD * 4 <= WS_PEB && WS_PEB + 2048 <= CTL_ZERO_BYTES, "d_ws map");
constexpr int CW_BAR = 4096;
constexpr int RING_BYTES = 131072, LDSCTL_OFF = 135168, MISC_OFF = LDSCTL_OFF + 320, LDS_BYTES = 147456;
static_assert(nsa::L_END <= LDSCTL_OFF && nsa::L_SELB + 512 <= nsa::L_END, "attention scratch below the LDS control words");

#define GAS __attribute__((address_space(1)))
#define LAS __attribute__((address_space(3)))
typedef unsigned short bf16;
typedef unsigned v4u __attribute__((ext_vector_type(4)));
typedef unsigned v2u __attribute__((ext_vector_type(2)));
typedef float f32x4 __attribute__((ext_vector_type(4)));
typedef GAS unsigned gu32;
#define RLX_AGENT __ATOMIC_RELAXED, __HIP_MEMORY_SCOPE_AGENT
#define LDS_WAIT() asm volatile("s_waitcnt lgkmcnt(0)" ::: "memory")
#define VM_WAIT() asm volatile("s_waitcnt vmcnt(0)" ::: "memory")
__device__ __forceinline__ unsigned f2bf(float f) { unsigned u = __builtin_bit_cast(unsigned, f); return (u + 0x7fffu + ((u >> 16) & 1u)) >> 16; }
__device__ __forceinline__ unsigned pk2(float lo, float hi) { return f2bf(lo) | (f2bf(hi) << 16); }
__device__ __forceinline__ float bf2f(unsigned short u) { return __builtin_bit_cast(float, (unsigned)u << 16); }
__device__ __forceinline__ float bflo(unsigned w) { return __builtin_bit_cast(float, w << 16); }
__device__ __forceinline__ float bfhi(unsigned w) { return __builtin_bit_cast(float, w & 0xffff0000u); }
#define XB_TMO      128
#define XB_XCNT(j)  (256  + 64 * (j))
#define XB_XSUB(j)  (1280 + 64 * (j))
#define XB_XGEN(j)  (2304 + 64 * (j))
#define XB_TOP      3328
#define XB_TOPGEN   3392
#define XCD_BAR_WORDS 3456
#define XB_SPIN_CAP (1u << 18)

__device__ __forceinline__ unsigned xb_ld(unsigned* p)              { return __hip_atomic_load(p, __ATOMIC_RELAXED, __HIP_MEMORY_SCOPE_AGENT); }
__device__ __forceinline__ unsigned xb_add(unsigned* p, unsigned v) { return __hip_atomic_fetch_add(p, v, __ATOMIC_RELAXED, __HIP_MEMORY_SCOPE_AGENT); }
__device__ __forceinline__ unsigned xb_xcc_id() { return (unsigned)__builtin_amdgcn_s_getreg((3 << 11) | 20) & 0xFu; }
#define XB_SPIN(cond, bar) do { unsigned _sp = 0; while (cond) { __builtin_amdgcn_s_sleep(1); \
    if ((++_sp & 255u) == 0u) { if (xb_ld(&(bar)[XB_TMO])) break; if (_sp > XB_SPIN_CAP) { atomicAdd(&(bar)[XB_TMO], 1u); break; } } } } while (0)

struct XcdBarrier {
    unsigned* bar; unsigned x;
    volatile LAS unsigned* st;
};

__device__ __forceinline__ XcdBarrier xcd_barrier_post(unsigned* bar, volatile LAS unsigned* st) {
    XcdBarrier b; b.bar = bar; b.x = xb_xcc_id(); b.st = st;
    if (threadIdx.x == 0) (void)xb_add(&bar[XB_XCNT(b.x)], 1u);
    return b;
}
__device__ __forceinline__ void xcd_barrier_complete(unsigned* bar, unsigned x, unsigned& nloc, unsigned& nx) {
    const unsigned G = gridDim.x * gridDim.y * gridDim.z;
    unsigned sum, cnt, mine, sp = 0u;
    for (;;) {
        sum = 0u; cnt = 0u; mine = 0u;
#pragma unroll
        for (unsigned j = 0; j < 16; ++j) { const unsigned c = xb_ld(&bar[XB_XCNT(j)]); sum += c; cnt += (c > 0u) ? 1u : 0u; mine = (j == x) ? c : mine; }
        if (sum == G) break;
        __builtin_amdgcn_s_sleep(1);
        if ((++sp & 255u) == 0u) { if (xb_ld(&bar[XB_TMO])) break; if (sp > XB_SPIN_CAP) { atomicAdd(&bar[XB_TMO], 1u); break; } }
    }
    nloc = mine > 0u ? mine : 1u; nx = cnt > 0u ? cnt : 1u;
}

__device__ __forceinline__ void xcd_barrier(const XcdBarrier& b) {
    asm volatile("s_waitcnt vmcnt(0)" ::: "memory");
    __syncthreads();
    if (threadIdx.x == 0) {
        unsigned* bar = b.bar;
        __builtin_amdgcn_s_waitcnt(0);
        unsigned nloc = b.st[0], nx = b.st[1];
        if (nloc == 0u) { xcd_barrier_complete(bar, b.x, nloc, nx); b.st[0] = nloc; b.st[1] = nx; }
        const unsigned old = xb_add(&bar[XB_XSUB(b.x)], 1u);
        const unsigned gen = old / nloc;
        if (old + 1u == (gen + 1u) * nloc) {
            __builtin_amdgcn_fence(__ATOMIC_RELEASE, "agent");
            asm volatile("s_waitcnt vmcnt(0)" ::: "memory");
            const unsigned og = xb_add(&bar[XB_TOP], 1u);
            const unsigned tg = og / nx;
            if (og + 1u == (tg + 1u) * nx) xb_add(&bar[XB_TOPGEN], 1u);
            else XB_SPIN(xb_ld(&bar[XB_TOPGEN]) == tg, bar);
            __builtin_amdgcn_fence(__ATOMIC_ACQUIRE, "agent");
            xb_add(&bar[XB_XGEN(b.x)], 1u);
            asm volatile("s_waitcnt vmcnt(0)" ::: "memory");
        } else {
            XB_SPIN(xb_ld(&bar[XB_XGEN(b.x)]) == gen, bar);
            __builtin_amdgcn_fence(__ATOMIC_ACQUIRE, "agent");
            asm volatile("s_waitcnt vmcnt(0)" ::: "memory");
        }
    }
    __syncthreads();
}
struct Args { const float* in[22]; float* out; unsigned char* ws; int ph_lo, ph_hi, li, pad; };
__device__ __forceinline__ float wave_sum(float v) {
#pragma unroll
    for (int o = 1; o < 64; o <<= 1) v += __shfl_xor(v, o);
    return v;
}
__device__ __forceinline__ float siluf(float x) { return x / (1.f + expf(-x)); }
__device__ __forceinline__ int ropeperm(int pp) { return 64 * ((pp >> 2) & 1) + 16 * (pp >> 5) + 4 * ((pp >> 3) & 3) + (pp & 3); }
__device__ __forceinline__ int inproj_src(int pr, float& scale) {
    scale = 1.f; const int pn = pr >> 8, p = pr & 255;
    if (pn == 0) { scale = 0.125f; return p; }
    if (pn == 1) return 256 + p;
    if (pn <= 3) return 512 + (pn - 2) * 256 + p;
    if (pn <= 5) return 1024 + (pn - 4) * 256 + p;
    if (pn <= 7) return 1552 + (2 * (pn - 6) + (p >> 7)) * 128 + ropeperm(p & 127);
    if (pn == 8) return 2064 + (p >> 7) * 128 + ropeperm(p & 127);
    if (pn == 9) return 2320 + p;
    if (pn == 10) return 2576 + (p >> 7) * 128 + ropeperm(p & 127);
    if (pn == 11) return 2832 + p;
    if (pn == 12) return 3088 + (p >> 7) * 128 + ropeperm(p & 127);
    if (pn == 13) return 3344 + p;
    return p < 16 ? 1536 + p : (p < 28 ? 3600 + (p - 16) : -1);
}
template <int MODE>
__device__ __forceinline__ void transpose_item(const float* W, int ldw, int K, bf16* WT, int k0, int n0, LAS float* scr, int lane) {
    int src = n0 + (lane & 31); float sc = 1.f;
    if (MODE == 1) src = inproj_src(n0 + (lane & 31), sc);
#pragma unroll 8
    for (int i = 0; i < 32; ++i) { const int kk = 2 * i + (lane >> 5); float v = 0.f; if (src >= 0) v = W[(size_t)(k0 + kk) * ldw + src] * sc; scr[kk * 33 + (lane & 31)] = v; }
    LDS_WAIT(); asm volatile("" ::: "memory");
    const int c = lane & 7;
#pragma unroll
    for (int j = 0; j < 4; ++j) { const int n = (lane >> 3) + 8 * j; const LAS float* s = scr + (8 * c) * 33 + n;
        v4u o; o.x = pk2(s[0 * 33], s[1 * 33]); o.y = pk2(s[2 * 33], s[3 * 33]); o.z = pk2(s[4 * 33], s[5 * 33]); o.w = pk2(s[6 * 33], s[7 * 33]);
        *(GAS v4u*)(WT + (size_t)(n0 + n) * K + k0 + 8 * c) = o; }
    LDS_WAIT(); asm volatile("" ::: "memory");
}
__device__ __forceinline__ void norm_mod_row(const float* xrow, const float* g, const float* sc, const float* sh, bf16* orow, int lane) {
    const GAS f32x4* xr = (const GAS f32x4*)xrow + lane; f32x4 v[4]; float ss = 0.f;
#pragma unroll
    for (int j = 0; j < 4; ++j) { v[j] = xr[64 * j]; ss += (v[j].x * v[j].x + v[j].y * v[j].y) + (v[j].z * v[j].z + v[j].w * v[j].w); }
    const float rstd = 1.f / sqrtf(wave_sum(ss) * (1.f / DM) + RMS_EPS);
    GAS unsigned long long* o8 = (GAS unsigned long long*)orow + lane;
#pragma unroll
    for (int j = 0; j < 4; ++j) { const int col = 4 * (lane + 64 * j); const f32x4 gv = *(const f32x4*)(g + col), sv = *(const GAS f32x4*)(sc + col), hv = *(const GAS f32x4*)(sh + col);
        const f32x4 y = v[j] * rstd * gv * (sv + 1.0f) + hv;
        o8[64 * j] = (unsigned long long)pk2(y.x, y.y) | ((unsigned long long)pk2(y.z, y.w) << 32); }
}

__device__ __forceinline__ void phase0(const Args& a, LAS unsigned char* lds, int tid, int lane, int wave, int vcu, int G) {
    unsigned char* ws = a.ws;
    { LAS float* sl = (LAS float*)lds;
      const float* c = a.in[1];
      for (int i = tid; i < 16 * 1024; i += NWAVES * 64) { const int b = i >> 10, k = i & 1023; sl[k * 16 + b] = siluf(c[i]); }
      __syncthreads();
      const int gt = (int)blockIdx.x * (NWAVES * 64) + tid;
      float* MOD = (float*)(ws + WS_MOD); float* PEB = (float*)(ws + WS_PEB);
      for (int id = gt; id < 6144 * 16 + 8192; id += G * NWAVES * 64) {
        if (id < 6144 * 16) { const int j = id % 6144, sli = id / 6144; const float* w = a.in[3] + (size_t)(sli * 64) * 6144 + j;
            float acc[16];
#pragma unroll
            for (int b = 0; b < 16; ++b) acc[b] = 0.f;
            for (int kk = 0; kk < 64; ++kk) { const float wv = w[(size_t)kk * 6144]; const LAS f32x4* sp = (const LAS f32x4*)(sl + (sli * 64 + kk) * 16);
#pragma unroll
                for (int q = 0; q < 4; ++q) { const f32x4 s4 = sp[q];
#pragma unroll
                    for (int i = 0; i < 4; ++i) acc[4 * q + i] += s4[i] * wv; } }
            const float bias = sli == 0 ? a.in[4][j] : 0.f;
#pragma unroll
            for (int b = 0; b < 16; ++b) atomicAdd(&MOD[b * 6144 + j], acc[b] + bias);
        } else { const int id2 = id - 6144 * 16, t = id2 >> 12, rem = id2 & 4095, j = rem & 255, sli = rem >> 8;
            const float* pe = a.in[10 + t] + sli * 256; const float* w1 = a.in[12 + 2 * t] + (size_t)(sli * 256) * 256 + j; float acc = 0.f;
            for (int kk = 0; kk < 256; ++kk) acc += pe[kk] * w1[(size_t)kk * 256];
            atomicAdd(&PEB[t * 256 + j], acc); }
      }
      __syncthreads(); }
    LAS float* scr = (LAS float*)(lds + wave * 16384);
    const int gw = vcu * NWAVES + wave, NGW = G * NWAVES;
    constexpr int I_IN = 16 * 120, I_O = 16 * 32, I_1 = 16 * 128, I_2 = 64 * 32, I_C = 64 * 8;
    for (int it = gw; it < I_IN + I_O + I_1 + I_2 + 2 * I_C; it += NGW) {
        int r = it;
        if (r < I_IN) { transpose_item<1>(a.in[6], DIN, DM, (bf16*)(ws + WS_WIN), 64 * (r / 120), 32 * (r % 120), scr, lane); continue; } r -= I_IN;
        if (r < I_O) { transpose_item<0>(a.in[17], DM, DM, (bf16*)(ws + WS_WO), 64 * (r / 32), 32 * (r % 32), scr, lane); continue; } r -= I_O;
        if (r < I_1) { transpose_item<0>(a.in[19], DFF, DM, (bf16*)(ws + WS_WFF1), 64 * (r / 128), 32 * (r % 128), scr, lane); continue; } r -= I_1;
        if (r < I_2) { transpose_item<0>(a.in[20], DM, DFF, (bf16*)(ws + WS_WFF2), 64 * (r / 32), 32 * (r % 32), scr, lane); continue; } r -= I_2;
        if (r < I_C) { transpose_item<0>(a.in[12], 256, 4096, (bf16*)(ws + WS_CKW1), 64 * (r / 8), 32 * (r % 8), scr, lane); continue; } r -= I_C;
        transpose_item<0>(a.in[14], 256, 4096, (bf16*)(ws + WS_CVW1), 64 * (r / 8), 32 * (r % 8), scr, lane);
    }
    { const int* pos = (const int*)a.in[2]; float* tab = (float*)(ws + WS_TAB);
      const float inv = exp2f(-(float)lane * (13.287712379549449f / 64.f));
      for (int m = gw; m < MTOK; m += NGW) { const float ang = (float)pos[m] * inv; double rev = (double)ang * 0.15915494309189535; rev -= rint(rev);
          const float r = (float)rev; typedef float f32x2 __attribute__((ext_vector_type(2)));
          *(GAS f32x2*)(tab + ((size_t)m * 64 + lane) * 2) = (f32x2){__builtin_amdgcn_cosf(r), __builtin_amdgcn_sinf(r)}; } }
}
__device__ __forceinline__ void gla_scalar_item(const Args& a, int item, int lane, LAS float* sq) {
    LAS float* sk = sq + 4096; LAS float* sa = sq + 8192; LAS float* sv = sq + 12288;
    const int bh = item >> 1, b = bh >> 2, h = bh & 3, e = (item & 1) * 64 + lane;
    const bf16* gla = (const bf16*)(a.ws + WS_GLA); const float* rg = (const float*)(a.ws + WS_RG); bf16* mix = (bf16*)(a.ws + WS_XN);
    float wa[16];
#pragma unroll
    for (int r = 0; r < 16; ++r) wa[r] = a.in[7][r * 256 + h * 64 + lane];
    const float ba = a.in[8][h * 64 + lane];
    float S[64];
#pragma unroll
    for (int d = 0; d < 64; ++d) S[d] = 0.f;
    for (int c = 0; c < 32; ++c) { const size_t m0 = (size_t)b * SEQ + c * 64;
#pragma unroll 4
        for (int tt = 0; tt < 64; ++tt) { const size_t m = m0 + tt;
            const float q = bf2f(gla[m * 1536 + h * 64 + lane]), k = bf2f(gla[m * 1536 + 256 + h * 64 + lane]), v = bf2f(gla[m * 1536 + 512 + h * 128 + e]);
            const float grv = rg[m * 32 + (lane & 15)]; float z = ba;
#pragma unroll
            for (int r = 0; r < 16; ++r) z += __shfl(grv, r) * wa[r];
            const float ls = fminf(z, 0.f) - log1pf(expf(-fabsf(z)));
            sq[tt * 64 + lane] = q; sk[tt * 64 + lane] = k; sa[tt * 64 + lane] = expf(ls * (1.f / 16.f)); sv[tt * 64 + lane] = v; }
        LDS_WAIT(); asm volatile("" ::: "memory");
        for (int tt = 0; tt < 64; ++tt) { const float v = sv[tt * 64 + lane]; float o = 0.f;
#pragma unroll
            for (int d4 = 0; d4 < 16; ++d4) { const f32x4 q4 = *(const LAS f32x4*)(sq + tt * 64 + 4 * d4), k4 = *(const LAS f32x4*)(sk + tt * 64 + 4 * d4), a4 = *(const LAS f32x4*)(sa + tt * 64 + 4 * d4);
#pragma unroll
                for (int i = 0; i < 4; ++i) { S[4 * d4 + i] = a4[i] * S[4 * d4 + i] + k4[i] * v; o += q4[i] * S[4 * d4 + i]; } }
            mix[(m0 + tt) * 1024 + h * 128 + e] = (bf16)f2bf(o); }
        LDS_WAIT(); asm volatile("" ::: "memory"); }
}
namespace gla {
typedef unsigned short bf16_t;
typedef short bf16x8 __attribute__((ext_vector_type(8)));
typedef short s16x4 __attribute__((ext_vector_type(4)));
typedef float f32x16 __attribute__((ext_vector_type(16)));
typedef float f32x4 __attribute__((ext_vector_type(4)));
typedef unsigned u32x4 __attribute__((ext_vector_type(4)));
typedef unsigned u32x2 __attribute__((ext_vector_type(2)));
constexpr int G_QIN = 0, G_KIN = 8192, G_KDT = 16384, G_V = 24576, G_O = 40960, OPITCH = 132, G_WA = G_O + 64 * OPITCH * 4, G_BA = G_WA + 4096, G_SEG = G_BA + 256, G_DEC = G_SEG + 2048, G_END = G_DEC + 256;
#define GL_LAS __attribute__((address_space(3)))
typedef float f32x2_t __attribute__((ext_vector_type(2))); typedef __bf16 bf16x2_t __attribute__((ext_vector_type(2)));
__device__ __forceinline__ unsigned cvtpk_s(float lo, float hi) { f32x2_t v = {lo, hi}; bf16x2_t b = __builtin_convertvector(v, bf16x2_t); return __builtin_bit_cast(unsigned, b); }
__device__ __forceinline__ float blo(unsigned w) { return __builtin_bit_cast(float, w << 16); }
__device__ __forceinline__ float bhi(unsigned w) { return __builtin_bit_cast(float, w & 0xffff0000u); }
__device__ __forceinline__ int crow(int r, int hi) { return (r & 3) + 8 * (r >> 2) + 4 * hi; }
__device__ __forceinline__ int v_st(int k, int c) { const int kk = (k & ~0xC) | ((k & 4) << 1) | ((k & 8) >> 1); return ((kk >> 3) * 4 + (c >> 5)) * 512 + ((kk & 7) * 32 + (c & 31)) * 2; }
__device__ __forceinline__ int v_rd_base(int lane) { return ((lane & 3) << 3) | (((lane >> 2) & 3) << 6) | (((lane >> 4) & 1) << 5) | (((lane >> 5) & 1) << 8); }
#define MFMA32(a, b, c) __builtin_amdgcn_mfma_f32_32x32x16_bf16((a), (b), (c), 0, 0, 0)
#define PK4G(P, B_, OUT) do { unsigned a0 = cvtpk_s(P[B_+0], P[B_+1]), a1 = cvtpk_s(P[B_+2], P[B_+3]), b0 = cvtpk_s(P[B_+4], P[B_+5]), b1 = cvtpk_s(P[B_+6], P[B_+7]);   \
        auto r0 = __builtin_amdgcn_permlane32_swap(a0, b0, false, false); auto r1 = __builtin_amdgcn_permlane32_swap(a1, b1, false, false);                     \
        u32x4 w = {r0[0], r1[0], r0[1], r1[1]}; OUT = __builtin_bit_cast(bf16x8, w); } while (0)

struct Pre { u32x4 q, k, va, vb, ga, gb; f32x4 r0, r1, r2, r3; };
__device__ __forceinline__ void load_pre(Pre& P, const bf16_t* gla, const float* rg, size_t m, int h, int dc) {
    const bf16_t* row = gla + m * 1536;
    P.q = *(const u32x4*)(row + h * 64 + 8 * dc); P.k = *(const u32x4*)(row + 256 + h * 64 + 8 * dc);
    P.va = *(const u32x4*)(row + 512 + h * 128 + 16 * dc); P.vb = *(const u32x4*)(row + 512 + h * 128 + 16 * dc + 8);
    P.ga = *(const u32x4*)(row + 1024 + h * 128 + 16 * dc); P.gb = *(const u32x4*)(row + 1024 + h * 128 + 16 * dc + 8);
    const f32x4* rp = (const f32x4*)(rg + m * 32); P.r0 = rp[0]; P.r1 = rp[1]; P.r2 = rp[2]; P.r3 = rp[3];
}

__device__ __forceinline__ void gla_unit(int b, int h, const bf16_t* glabuf, const float* rg, const float* w_a2, const float* b_a, const float* norm_g, bf16_t* mix, GL_LAS unsigned char* lds) {
    int tid = threadIdx.x; asm volatile("" : "+v"(tid));
    const int lane = tid & 63, wid = __builtin_amdgcn_readfirstlane(tid >> 6), r32 = lane & 31, hi = lane >> 5, rb = wid >> 2, eq = wid & 3;
    const int t = tid >> 3, dc = tid & 7;
    GL_LAS float* WA = (GL_LAS float*)(lds + G_WA); GL_LAS float* BA = (GL_LAS float*)(lds + G_BA); GL_LAS float* SEG = (GL_LAS float*)(lds + G_SEG); GL_LAS float* DEC = (GL_LAS float*)(lds + G_DEC);
    GL_LAS float* OB = (GL_LAS float*)(lds + G_O);
    for (int i = tid; i < 16 * 64; i += 512) WA[i] = w_a2[(i >> 6) * 256 + h * 64 + (i & 63)];
    if (tid < 64) BA[tid] = b_a[h * 64 + tid];
    float gn[16];
#pragma unroll
    for (int i = 0; i < 16; ++i) gn[i] = norm_g[h * 128 + 16 * dc + i];
    f32x16 S0 = {}, S1 = {};
    const size_t mbase = (size_t)b * SEQ;
    Pre P; load_pre(P, glabuf, rg, mbase + t, h, dc);
    __syncthreads();
    for (int c = 0; c < 32; ++c) {
        float la[8];
        { float z[8];
          const GL_LAS f32x4* bp = (const GL_LAS f32x4*)(BA + 8 * dc); const f32x4 b0 = bp[0], b1 = bp[1];
          z[0] = b0[0]; z[1] = b0[1]; z[2] = b0[2]; z[3] = b0[3]; z[4] = b1[0]; z[5] = b1[1]; z[6] = b1[2]; z[7] = b1[3];
          const float g[16] = {P.r0[0], P.r0[1], P.r0[2], P.r0[3], P.r1[0], P.r1[1], P.r1[2], P.r1[3], P.r2[0], P.r2[1], P.r2[2], P.r2[3], P.r3[0], P.r3[1], P.r3[2], P.r3[3]};
#pragma unroll
          for (int r = 0; r < 16; ++r) { const GL_LAS f32x4* wp = (const GL_LAS f32x4*)(WA + r * 64 + 8 * dc); const f32x4 w0 = wp[0], w1 = wp[1];
              z[0] += g[r] * w0[0]; z[1] += g[r] * w0[1]; z[2] += g[r] * w0[2]; z[3] += g[r] * w0[3]; z[4] += g[r] * w1[0]; z[5] += g[r] * w1[1]; z[6] += g[r] * w1[2]; z[7] += g[r] * w1[3]; }
#pragma unroll
          for (int i = 0; i < 8; ++i) la[i] = (fminf(z[i], 0.f) - __logf(1.f + __expf(-fabsf(z[i])))) * (1.f / 16.f); }
#pragma unroll
        for (int off = 8; off < 64; off <<= 1) {
#pragma unroll
            for (int i = 0; i < 8; ++i) { const float u = __shfl_up(la[i], off); if (lane >= off) la[i] += u; } }
        if ((lane >> 3) == 7) { *(GL_LAS f32x4*)(SEG + wid * 64 + 8 * dc) = (f32x4){la[0], la[1], la[2], la[3]}; *(GL_LAS f32x4*)(SEG + wid * 64 + 8 * dc + 4) = (f32x4){la[4], la[5], la[6], la[7]}; }
        __syncthreads();
        float bl[8];
#pragma unroll
        for (int i = 0; i < 8; ++i) bl[i] = 0.f;
#pragma unroll
        for (int w = 0; w < 8; ++w) { const f32x4 s0 = *(const GL_LAS f32x4*)(SEG + w * 64 + 8 * dc), s1 = *(const GL_LAS f32x4*)(SEG + w * 64 + 8 * dc + 4);
            const float sv[8] = {s0[0], s0[1], s0[2], s0[3], s1[0], s1[1], s1[2], s1[3]};
#pragma unroll
            for (int i = 0; i < 8; ++i) { bl[i] += sv[i]; if (w < wid) la[i] += sv[i]; } }
        { const float qf[8] = {blo(P.q.x), bhi(P.q.x), blo(P.q.y), bhi(P.q.y), blo(P.q.z), bhi(P.q.z), blo(P.q.w), bhi(P.q.w)};
          const float kf[8] = {blo(P.k.x), bhi(P.k.x), blo(P.k.y), bhi(P.k.y), blo(P.k.z), bhi(P.k.z), blo(P.k.w), bhi(P.k.w)};
          float qi[8], ki[8], kd[8];
#pragma unroll
          for (int i = 0; i < 8; ++i) { qi[i] = qf[i] * __expf(la[i]); ki[i] = kf[i] * __expf(-la[i]); kd[i] = kf[i] * __expf(bl[i] - la[i]); }
          const int swz = ((dc ^ (t & 7)) << 4);
          *(GL_LAS u32x4*)(lds + G_QIN + t * 128 + swz) = (u32x4){cvtpk_s(qi[0], qi[1]), cvtpk_s(qi[2], qi[3]), cvtpk_s(qi[4], qi[5]), cvtpk_s(qi[6], qi[7])};
          *(GL_LAS u32x4*)(lds + G_KIN + t * 128 + swz) = (u32x4){cvtpk_s(ki[0], ki[1]), cvtpk_s(ki[2], ki[3]), cvtpk_s(ki[4], ki[5]), cvtpk_s(ki[6], ki[7])};
#pragma unroll
          for (int i = 0; i < 8; ++i) { const int d = 8 * dc + i; *(GL_LAS unsigned short*)(lds + G_KDT + d * 128 + (((t >> 3) ^ (d & 7)) << 4) + (t & 7) * 2) = (unsigned short)(cvtpk_s(kd[i], 0.f) & 0xffffu); }
          if (t == 0) { *(GL_LAS f32x4*)(DEC + 8 * dc) = (f32x4){__expf(bl[0]), __expf(bl[1]), __expf(bl[2]), __expf(bl[3])}; *(GL_LAS f32x4*)(DEC + 8 * dc + 4) = (f32x4){__expf(bl[4]), __expf(bl[5]), __expf(bl[6]), __expf(bl[7])}; }
          *(GL_LAS u32x4*)(lds + G_V + v_st(t, 16 * dc)) = P.va; *(GL_LAS u32x4*)(lds + G_V + v_st(t, 16 * dc + 8)) = P.vb; }
        const u32x4 ga = P.ga, gb = P.gb;
        if (c + 1 < 32) load_pre(P, glabuf, rg, mbase + (size_t)(c + 1) * 64 + t, h, dc);
        __syncthreads();
        { const int crw = 32 * rb + r32;
          f32x16 p0 = {}, p1 = {};
#pragma unroll
          for (int d0 = 0; d0 < 4; ++d0) { const int ch = 2 * d0 + hi;
              const bf16x8 qv = *(const GL_LAS bf16x8*)(lds + G_QIN + crw * 128 + ((ch ^ (crw & 7)) << 4));
              const bf16x8 k0 = *(const GL_LAS bf16x8*)(lds + G_KIN + r32 * 128 + ((ch ^ (r32 & 7)) << 4));
              p0 = MFMA32(k0, qv, p0);
              if (rb) { const bf16x8 k1 = *(const GL_LAS bf16x8*)(lds + G_KIN + (32 + r32) * 128 + ((ch ^ (r32 & 7)) << 4)); p1 = MFMA32(k1, qv, p1); } }
#pragma unroll
          for (int r = 0; r < 16; ++r) { const bool keep = crow(r, hi) <= r32; if (rb) p1[r] = keep ? p1[r] : 0.f; else p0[r] = keep ? p0[r] : 0.f; }
          bf16x8 pa0, pa1, pa2, pa3; PK4G(p0, 0, pa0); PK4G(p0, 8, pa1); PK4G(p1, 0, pa2); PK4G(p1, 8, pa3);
          const int vb = G_V + v_rd_base(lane) + eq * 512; bf16x8 vf[4];
#pragma unroll
          for (int ks = 0; ks < 4; ++ks) { const s16x4 lo = __builtin_bit_cast(s16x4, __builtin_amdgcn_ds_read_tr16_b64_v4i16((GL_LAS s16x4*)(lds + vb + ks * 4096)));
              const s16x4 hh = __builtin_bit_cast(s16x4, __builtin_amdgcn_ds_read_tr16_b64_v4i16((GL_LAS s16x4*)(lds + vb + ks * 4096 + 2048)));
              vf[ks] = (bf16x8){lo[0], lo[1], lo[2], lo[3], hh[0], hh[1], hh[2], hh[3]}; }
          f32x16 o = {};
          o = MFMA32(pa0, vf[0], o); o = MFMA32(pa1, vf[1], o);
          if (rb) { o = MFMA32(pa2, vf[2], o); o = MFMA32(pa3, vf[3], o); }
#pragma unroll
          for (int s = 0; s < 4; ++s) {
              const u32x2 a_lo = *(const GL_LAS u32x2*)(lds + G_QIN + crw * 128 + (((2 * s) ^ (crw & 7)) << 4) + 8 * hi);
              const u32x2 a_hi = *(const GL_LAS u32x2*)(lds + G_QIN + crw * 128 + (((2 * s + 1) ^ (crw & 7)) << 4) + 8 * hi);
              const u32x4 aw = {a_lo.x, a_lo.y, a_hi.x, a_hi.y};
              u32x4 bw;
              if (s == 0) bw = (u32x4){cvtpk_s(S0[0], S0[1]), cvtpk_s(S0[2], S0[3]), cvtpk_s(S0[4], S0[5]), cvtpk_s(S0[6], S0[7])};
              else if (s == 1) bw = (u32x4){cvtpk_s(S0[8], S0[9]), cvtpk_s(S0[10], S0[11]), cvtpk_s(S0[12], S0[13]), cvtpk_s(S0[14], S0[15])};
              else if (s == 2) bw = (u32x4){cvtpk_s(S1[0], S1[1]), cvtpk_s(S1[2], S1[3]), cvtpk_s(S1[4], S1[5]), cvtpk_s(S1[6], S1[7])};
              else bw = (u32x4){cvtpk_s(S1[8], S1[9]), cvtpk_s(S1[10], S1[11]), cvtpk_s(S1[12], S1[13]), cvtpk_s(S1[14], S1[15])};
              o = MFMA32(__builtin_bit_cast(bf16x8, aw), __builtin_bit_cast(bf16x8, bw), o); }
#pragma unroll
          for (int rq = 0; rq < 4; ++rq) { const f32x4 d0v = *(const GL_LAS f32x4*)(DEC + 8 * rq + 4 * hi), d1v = *(const GL_LAS f32x4*)(DEC + 32 + 8 * rq + 4 * hi);
#pragma unroll
              for (int i = 0; i < 4; ++i) { S0[4 * rq + i] *= d0v[i]; S1[4 * rq + i] *= d1v[i]; } }
#pragma unroll
          for (int ks = 0; ks < 4; ++ks) { const int ch = 2 * ks + hi;
              const bf16x8 a0 = *(const GL_LAS bf16x8*)(lds + G_KDT + r32 * 128 + ((ch ^ (r32 & 7)) << 4));
              const bf16x8 a1 = *(const GL_LAS bf16x8*)(lds + G_KDT + (32 + r32) * 128 + ((ch ^ (r32 & 7)) << 4));
              S0 = MFMA32(a0, vf[ks], S0); S1 = MFMA32(a1, vf[ks], S1); }
#pragma unroll
          for (int r = 0; r < 16; ++r) OB[(32 * rb + crow(r, hi)) * OPITCH + 32 * eq + r32] = o[r]; }
        __syncthreads();
        { const GL_LAS f32x4* op = (const GL_LAS f32x4*)(OB + t * OPITCH + 16 * dc); const f32x4 o0 = op[0], o1 = op[1], o2 = op[2], o3 = op[3];
          const float ov[16] = {o0[0], o0[1], o0[2], o0[3], o1[0], o1[1], o1[2], o1[3], o2[0], o2[1], o2[2], o2[3], o3[0], o3[1], o3[2], o3[3]};
          float ss = 0.f;
#pragma unroll
          for (int i = 0; i < 16; ++i) ss += ov[i] * ov[i];
          ss += __shfl_xor(ss, 1); ss += __shfl_xor(ss, 2); ss += __shfl_xor(ss, 4);
          const float rstd = 1.f / sqrtf(ss * (1.f / 128.f) + RMS_EPS);
          const float gg[16] = {blo(ga.x), bhi(ga.x), blo(ga.y), bhi(ga.y), blo(ga.z), bhi(ga.z), blo(ga.w), bhi(ga.w), blo(gb.x), bhi(gb.x), blo(gb.y), bhi(gb.y), blo(gb.z), bhi(gb.z), blo(gb.w), bhi(gb.w)};
          float y[16];
#pragma unroll
          for (int i = 0; i < 16; ++i) y[i] = ov[i] * rstd * gn[i] * (gg[i] / (1.f + __expf(-gg[i])));
          bf16_t* orow = mix + (mbase + (size_t)c * 64 + t) * 1024 + h * 128 + 16 * dc;
          *(u32x4*)orow = (u32x4){cvtpk_s(y[0], y[1]), cvtpk_s(y[2], y[3]), cvtpk_s(y[4], y[5]), cvtpk_s(y[6], y[7])};
          *(u32x4*)(orow + 8) = (u32x4){cvtpk_s(y[8], y[9]), cvtpk_s(y[10], y[11]), cvtpk_s(y[12], y[13]), cvtpk_s(y[14], y[15])}; }
    }
    __syncthreads();
}
#undef PK4G
#undef MFMA32
}
__global__ void __launch_bounds__(NWAVES * 64, 2) fwd_kernel(Args args) {
    extern __shared__ __attribute__((aligned(16))) unsigned char lds_g[];
    LAS unsigned char* lds = (LAS unsigned char*)lds_g;
    volatile LAS unsigned* MISC = (volatile LAS unsigned*)(lds + MISC_OFF);
#define PHASE_IDS() int tid = threadIdx.x; asm volatile("" : "+v"(tid)); const int lane = tid & 63, wave = __builtin_amdgcn_readfirstlane(tid >> 6); const int gw = vcu * NWAVES + wave, NGW = G * NWAVES; (void)lane; (void)gw; (void)NGW;
    const int G = gridDim.x; const int bx = blockIdx.x; const int vcu = (G % 8 == 0) ? (bx % 8) * (G / 8) + bx / 8 : bx;
    unsigned char* ws = args.ws; gu32* ctl = (gu32*)(ws + WS_CTL);
    for (int u = threadIdx.x; u < (LDS_BYTES - LDSCTL_OFF) / 4; u += NWAVES * 64) ((LAS unsigned*)(lds + LDSCTL_OFF))[u] = 0u;
    __syncthreads();
    XcdBarrier bar; bar.bar = (unsigned*)(ctl + CW_BAR) + args.li * XCD_BAR_WORDS; bar.x = 0; bar.st = nullptr;
    if (N_LAUNCHES != N_PHASES) bar = xcd_barrier_post((unsigned*)(ctl + CW_BAR) + args.li * XCD_BAR_WORDS, MISC + 8);
    const int lo = args.ph_lo, hi = args.ph_hi;
#ifndef PH_MASK
#define PH_MASK 0xfff
#endif
#define IN(k) (((PH_MASK >> (k)) & 1) && lo <= (k) && (k) < hi)
#define SEAM(k) do { if (IN(k) && IN((k) + 1)) xcd_barrier(bar); } while (0)
#ifndef PROBE_DUP
#define PROBE_DUP -1
#endif
    float* MOD = (float*)(ws + WS_MOD);
    bf16* XN = (bf16*)(ws + WS_XN);

    if (IN(0)) { PHASE_IDS(); phase0(args, lds, tid, lane, wave, vcu, G); } SEAM(0);
    if (IN(1)) { PHASE_IDS(); for (int m = gw; m < MTOK; m += NGW) { const int b = m / SEQ; norm_mod_row(args.in[0] + (size_t)m * DM, args.in[5], MOD + b * NMOD + 1024, MOD + b * NMOD, XN + (size_t)m * DM, lane); } } SEAM(1);
    if (IN(2)) { PHASE_IDS(); pg8::Gemm g{XN, (const bf16*)(ws + WS_WIN), MTOK, NPROJ, DM, DM}; pg8::StaticOrder S; S.init(MTOK, NPROJ, G, bx);
        pg8::EpiInProj E{(bf16*)(ws + WS_GLA), (bf16*)(ws + WS_NQ), (bf16*)(ws + WS_KV), KV_STRIDE_B / 2, (float*)(ws + WS_RG), (const float*)(ws + WS_TAB)};
        pg8::gemm_phase<pg8::EpiInProj, pg8::StaticOrder, true, true>(lds, g, S, E); } SEAM(2);
    if (IN(3)) for (int rep = 0; rep < (PROBE_DUP == 3 ? 2 : 1); ++rep) { PHASE_IDS();
        if (bx < 32) { const int t = bx >> 4;
            pg8::Gemm g{(const bf16*)(ws + WS_KV + (size_t)t * KV_STRIDE_B), (const bf16*)(ws + (t ? WS_CVW1 : WS_CKW1)), 4096, 256, 4096, 2048}; pg8::OneUnit S{bx & 15, 0};
            pg8::EpiActBf16<1> E{(bf16*)(ws + WS_HID) + (size_t)t * 4096 * 256, 256, (const float*)(ws + WS_PEB) + t * 256};
            pg8::gemm_phase<pg8::EpiActBf16<1>, pg8::OneUnit, true, true>(lds, g, S, E);
#ifndef GLA_MFMA
#define GLA_MFMA 1
#endif
        } else if (GLA_MFMA && bx < 96) { const int u = bx - 32;
            gla::gla_unit(u >> 2, u & 3, (const bf16*)(ws + WS_GLA), (const float*)(ws + WS_RG), args.in[7], args.in[8], args.in[9], XN, lds);
        } else if (!GLA_MFMA && bx < 160) { if (wave == 0) gla_scalar_item(args, bx - 32, lane, (LAS float*)lds); }
    } SEAM(3);
    if (IN(4)) { PHASE_IDS(); LAS float* hrow = (LAS float*)(lds + wave * 1024);
        for (int item = gw; item < 8192; item += NGW) { const int t = item >> 12, m = item & 4095;
            const v2u hv = *(const GAS v2u*)((const bf16*)(ws + WS_HID) + ((size_t)t * 4096 + m) * 256 + 4 * lane);
            *(LAS f32x4*)(hrow + 4 * lane) = (f32x4){bflo(hv.x), bfhi(hv.x), bflo(hv.y), bfhi(hv.y)};
            LDS_WAIT(); asm volatile("" ::: "memory");
            const float* w2 = args.in[13 + 2 * t]; float a0 = 0.f, a1 = 0.f;
#pragma unroll 4
            for (int j4 = 0; j4 < 64; ++j4) { const f32x4 h4 = *(const LAS f32x4*)(hrow + 4 * j4);
#pragma unroll
                for (int i = 0; i < 4; ++i) { a0 += h4[i] * w2[(4 * j4 + i) * 128 + lane]; a1 += h4[i] * w2[(4 * j4 + i) * 128 + 64 + lane]; } }
            bf16* o = (bf16*)(ws + (t ? WS_VCMP : WS_KCMP)) + (size_t)m * 128; o[lane] = (bf16)f2bf(a0); o[64 + lane] = (bf16)f2bf(a1);
            LDS_WAIT(); asm volatile("" ::: "memory"); } } SEAM(4);
    if (IN(5)) for (int rep = 0; rep < (PROBE_DUP == 5 ? 2 : 1); ++rep) { PHASE_IDS(); const bf16* NQ = (const bf16*)(ws + WS_NQ); const int g = wave >> 2, qrel = 32 * (wave & 3);
        unsigned* SELG = (unsigned*)(ws + WS_SEL);
#ifndef NSA_PARTS
#define NSA_PARTS 7
#endif
#define NSA_UNIT_VARS const int bh = item >> 3, x = item & 7, b = bh >> 1, hk = bh & 1; const int qb = pass ? x : 15 - x, P0 = qb * 128; \
                const bf16* Qw = NQ + ((size_t)(b * 4 + 2 * hk + g) * SEQ + P0 + qrel) * 128; \
                bf16* Ow = (bf16*)(ws + WS_OBR) + (size_t)(b * SEQ + P0 + qrel) * 512 + (2 * hk + g) * 128; \
                const size_t kvo = (size_t)bh * SEQ * 128; unsigned* selg = SELG + (size_t)bh * SEQ + P0; (void)kvo; (void)Ow; (void)Qw; (void)selg;
        if (NSA_PARTS & 1) for (int item = vcu; item < 256; item += G) for (int pass = 0; pass < 2; ++pass) { NSA_UNIT_VARS
                nsa::cmp_branch(Qw, (const bf16*)(ws + WS_KCMP) + (size_t)bh * 128 * 128, (const bf16*)(ws + WS_VCMP) + (size_t)bh * 128 * 128, Ow, 512, P0, qrel, g, selg, (char*)lds_g); }
        if (NSA_PARTS & 2) for (int item = vcu; item < 256; item += G) for (int pass = 0; pass < 2; ++pass) { NSA_UNIT_VARS
                nsa::attn_branch<true>(Qw, (const bf16*)(ws + WS_KV + 2 * KV_STRIDE_B) + kvo, (const bf16*)(ws + WS_KV + 3 * KV_STRIDE_B) + kvo, Ow + OBR_STRIDE_B / 2, 512, P0, qrel, 0x40000000, selg, (char*)lds_g); }
        if (NSA_PARTS & 4) for (int item = vcu; item < 256; item += G) for (int pass = 0; pass < 2; ++pass) { NSA_UNIT_VARS
                nsa::attn_branch<false>(Qw, (const bf16*)(ws + WS_KV + 4 * KV_STRIDE_B) + kvo, (const bf16*)(ws + WS_KV + 5 * KV_STRIDE_B) + kvo, Ow + OBR_STRIDE_B, 512, P0, qrel, 512, nullptr, (char*)lds_g); }
    } SEAM(5);
    if (IN(6)) { PHASE_IDS(); const bf16* OBR = (const bf16*)(ws + WS_OBR); const float* rg = (const float*)(ws + WS_RG); const bf16* gla = (const bf16*)(ws + WS_GLA);
        for (int m = gw; m < MTOK; m += NGW) { const int hq = lane >> 4; float gt[3];
#pragma unroll
            for (int br = 0; br < 3; ++br) { const float z = rg[(size_t)m * 32 + 16 + hq * 3 + br]; gt[br] = 1.f / (1.f + expf(-z)); }
            float o[8];
#pragma unroll
            for (int i = 0; i < 8; ++i) o[i] = 0.f;
#pragma unroll
            for (int br = 0; br < 3; ++br) { const v4u w = *(const GAS v4u*)(OBR + (size_t)br * (OBR_STRIDE_B / 2) + (size_t)m * 512 + 8 * lane);
                o[0] += gt[br] * bflo(w.x); o[1] += gt[br] * bfhi(w.x); o[2] += gt[br] * bflo(w.y); o[3] += gt[br] * bfhi(w.y);
                o[4] += gt[br] * bflo(w.z); o[5] += gt[br] * bfhi(w.z); o[6] += gt[br] * bflo(w.w); o[7] += gt[br] * bfhi(w.w); }
            float ss = 0.f;
#pragma unroll
            for (int i = 0; i < 8; ++i) ss += o[i] * o[i];
            const float rstd = 1.f / sqrtf(wave_sum(ss) * (1.f / 512.f) + RMS_EPS);
            const f32x4 g0 = *(const f32x4*)(args.in[16] + 8 * lane), g1 = *(const f32x4*)(args.in[16] + 8 * lane + 4);
            v4u w; w.x = pk2(o[0] * rstd * g0[0], o[1] * rstd * g0[1]); w.y = pk2(o[2] * rstd * g0[2], o[3] * rstd * g0[3]);
            w.z = pk2(o[4] * rstd * g1[0], o[5] * rstd * g1[1]); w.w = pk2(o[6] * rstd * g1[2], o[7] * rstd * g1[3]);
            *(GAS v4u*)(XN + (size_t)m * DM + 512 + 8 * lane) = w;
            if (!GLA_MFMA) {
            const v4u r = *(const GAS v4u*)(XN + (size_t)m * DM + 8 * lane); const v4u gg = *(const GAS v4u*)(gla + (size_t)m * 1536 + 1024 + 8 * lane);
            float v[8] = {bflo(r.x), bfhi(r.x), bflo(r.y), bfhi(r.y), bflo(r.z), bfhi(r.z), bflo(r.w), bfhi(r.w)};
            float q[8] = {bflo(gg.x), bfhi(gg.x), bflo(gg.y), bfhi(gg.y), bflo(gg.z), bfhi(gg.z), bflo(gg.w), bfhi(gg.w)};
            float s2 = 0.f;
#pragma unroll
            for (int i = 0; i < 8; ++i) s2 += v[i] * v[i];
            s2 += __shfl_xor(s2, 1); s2 += __shfl_xor(s2, 2); s2 += __shfl_xor(s2, 4); s2 += __shfl_xor(s2, 8);
            const float rs2 = 1.f / sqrtf(s2 * (1.f / 128.f) + RMS_EPS);
            const f32x4 h0 = *(const f32x4*)(args.in[9] + 8 * lane), h1 = *(const f32x4*)(args.in[9] + 8 * lane + 4);
            float y[8];
#pragma unroll
            for (int i = 0; i < 8; ++i) y[i] = v[i] * rs2 * (i < 4 ? h0[i & 3] : h1[i & 3]) * siluf(q[i]);
            v4u w2; w2.x = pk2(y[0], y[1]); w2.y = pk2(y[2], y[3]); w2.z = pk2(y[4], y[5]); w2.w = pk2(y[6], y[7]);
            *(GAS v4u*)(XN + (size_t)m * DM + 8 * lane) = w2; } } } SEAM(6);
    if (IN(7)) { PHASE_IDS(); pg8::Gemm g{XN, (const bf16*)(ws + WS_WO), MTOK, DM, DM, DM}; pg8::StaticOrder S; S.init(MTOK, DM, G, bx);
        pg8::EpiResid E{args.in[0], args.out, MOD + 2048};
        pg8::gemm_phase<pg8::EpiResid, pg8::StaticOrder, true, true>(lds, g, S, E); } SEAM(7);
    if (IN(8)) { PHASE_IDS(); for (int m = gw; m < MTOK; m += NGW) { const int b = m / SEQ; norm_mod_row(args.out + (size_t)m * DM, args.in[18], MOD + b * NMOD + 4096, MOD + b * NMOD + 3072, XN + (size_t)m * DM, lane); } } SEAM(8);
    if (IN(9)) { PHASE_IDS(); pg8::Gemm g{XN, (const bf16*)(ws + WS_WFF1), MTOK, DFF, DM, DM}; pg8::StaticOrder S; S.init(MTOK, DFF, G, bx);
        pg8::EpiActBf16<2> E{(bf16*)(ws + WS_H), DFF, nullptr};
        pg8::gemm_phase<pg8::EpiActBf16<2>, pg8::StaticOrder, true, true>(lds, g, S, E); } SEAM(9);
    if (IN(10)) { PHASE_IDS(); pg8::Gemm g{(const bf16*)(ws + WS_H), (const bf16*)(ws + WS_WFF2), MTOK, DM, DFF, DFF}; pg8::StaticOrder S; S.init(MTOK, DM, G, bx);
        pg8::EpiResid E{args.out, args.out, MOD + 5120};
        pg8::gemm_phase<pg8::EpiResid, pg8::StaticOrder, true, true>(lds, g, S, E); } SEAM(10);
    if (IN(11)) { PHASE_IDS(); for (int m = gw; m < MTOK; m += NGW) { GAS f32x4* xr = (GAS f32x4*)(args.out + (size_t)m * DM) + lane; f32x4 v[4]; float ss = 0.f;
#pragma unroll
            for (int j = 0; j < 4; ++j) { v[j] = xr[64 * j]; ss += (v[j].x * v[j].x + v[j].y * v[j].y) + (v[j].z * v[j].z + v[j].w * v[j].w); }
            const float rstd = 1.f / sqrtf(wave_sum(ss) * (1.f / DM) + RMS_EPS);
#pragma unroll
            for (int j = 0; j < 4; ++j) xr[64 * j] = v[j] * rstd * *(const f32x4*)(args.in[21] + 4 * (lane + 64 * j)); } }
#undef IN
#undef SEAM
}

extern "C" void kernel_launch(void* const* d_in, const int* in_sizes, int n_in, void* d_out, int out_size, void* d_ws, size_t ws_size, hipStream_t stream) {
    static int grid = 0;
    if (grid == 0) {
        if (n_in != 22 || in_sizes[0] != MTOK * DM || out_size != MTOK * DM || ws_size < WS_END) { fprintf(stderr, "kernel_launch: unexpected shapes (n_in %d, in0 %d, out %d, ws %zu)\n", n_in, n_in > 0 ? in_sizes[0] : -1, out_size, ws_size); grid = -1; return; }
        if (hipFuncSetAttribute((const void*)fwd_kernel, hipFuncAttributeMaxDynamicSharedMemorySize, LDS_BYTES) != hipSuccess) { fprintf(stderr, "kernel_launch: hipFuncSetAttribute failed\n"); grid = -1; return; }
        int per_cu = 0;
        if (hipOccupancyMaxActiveBlocksPerMultiprocessor(&per_cu, (const void*)fwd_kernel, NWAVES * 64, LDS_BYTES) != hipSuccess || per_cu < 1) fprintf(stderr, "kernel_launch: occupancy query reports %d workgroups per CU\n", per_cu);
        (void)hipGetLastError();
        grid = 256;
    }
    if (grid < 0) return;
    if (hipMemsetAsync((char*)d_ws + WS_CTL, 0, CTL_ZERO_BYTES, stream) != hipSuccess) { fprintf(stderr, "kernel_launch: hipMemsetAsync failed\n"); return; }
    Args a{};
    for (int i = 0; i < 22; ++i) a.in[i] = (const float*)d_in[i];
    a.out = (float*)d_out; a.ws = (unsigned char*)d_ws;
    for (int li = 0; li < N_LAUNCHES; ++li) {
        a.ph_lo = (N_LAUNCHES == 1) ? 0 : li; a.ph_hi = (N_LAUNCHES == 1) ? N_PHASES : li + 1; a.li = (N_LAUNCHES == 1) ? 0 : 0;
        hipLaunchKernelGGL(fwd_kernel, dim3(grid), dim3(NWAVES * 64), LDS_BYTES, stream, a);
        const hipError_t le = hipPeekAtLastError();
        if (le != hipSuccess) { fprintf(stderr, "kernel_launch: launch %d failed: %s\n", li, hipGetErrorName(le)); break; }
    }
}
```

```cpp
#include <hip/hip_runtime.h>
#include <cstdio>
#include <cstdint>
#include <cmath>

constexpr int BATCH = 16, SEQ = 2048, DM = 1024, MTOK = BATCH * SEQ, DFF = 4096, DIN = 3612, NPROJ = 3840, NMOD = 6 * DM;
constexpr float RMS_EPS = 1e-6f;

namespace pg8 {
#define PG8_LAS __attribute__((address_space(3)))
typedef unsigned short bf16_t;
typedef short bf16x8 __attribute__((ext_vector_type(8)));
typedef float f32x4 __attribute__((ext_vector_type(4)));
typedef unsigned u32x4 __attribute__((ext_vector_type(4)));
constexpr int BM = 256, BK = 64, HALF = 128, HTB = HALF * BK * 2  , STAGE_BYTES = 8 * HTB, NXCD = 8, WGM = 8;

__host__ __device__ __forceinline__ int lds_byte(int r, int c) { const int st = (r >> 4) * 2 + (c >> 5), rr = r & 15, cc = c & 31, ob = rr * 64 + cc * 2; return st * 1024 + (ob ^ (((ob >> 9) & 1) << 5)); }
__host__ __device__ __forceinline__ void stage_rc(int b, int& R, int& C) { const int st = b / 1024, sb = b % 1024, swz = sb ^ (((sb >> 9) & 1) << 5); R = (st >> 1) * 16 + swz / 64; C = (st & 1) * 32 + (swz % 64) / 2; }
__host__ __device__ __forceinline__ int perm32(int rho) { const int n = rho >> 4, i = rho & 15; return 8 * (i >> 2) + 4 * n + (i & 3); }

struct Unit { int pm, pn; };
struct Gemm { const bf16_t* A; const bf16_t* Bt; int M, N, K, lda; };

struct StaticOrder {
    int nM, nN, nwg, G, c;
    __host__ __device__ void init(int M, int N, int G_, int c_) { nM = M / BM; nN = N / BM; nwg = nM * nN; G = G_; c = c_; }
    __host__ __device__ bool next(int i, Unit& u) const {
        const long L = (long)i * G + c; if (L >= nwg) return false;
        int wgid = (int)L; { const int q = nwg / NXCD, r = nwg % NXCD, xcd = wgid % NXCD, off = wgid / NXCD; wgid = (xcd < r ? xcd * (q + 1) : r * (q + 1) + (xcd - r) * q) + off; }
        const int nig = WGM * nN, gid = wgid / nig, fm = gid * WGM, gsz = (nM - fm) < WGM ? (nM - fm) : WGM;
        u.pm = fm + ((wgid % nig) % gsz); u.pn = (wgid % nig) / gsz; return true;
    }
    __device__ __forceinline__ void a_ready(const Unit&) const {}
    __device__ __forceinline__ void done(const Unit&) const {}
};

__device__ __forceinline__ unsigned cvt_pk_bf16(float lo, float hi) { unsigned r; asm volatile("v_cvt_pk_bf16_f32 %0, %1, %2" : "=v"(r) : "v"(lo), "v"(hi)); return r; }
typedef unsigned u32x2 __attribute__((ext_vector_type(2)));
struct OneUnit { int pm, pn;
    __device__ __forceinline__ bool next(int i, Unit& u) const { if (i) return false; u.pm = pm; u.pn = pn; return true; }
    __device__ __forceinline__ void a_ready(const Unit&) const {}
    __device__ __forceinline__ void done(const Unit&) const {} };

struct EpiInProj {
    static constexpr bool PERM = true, AFTER_DRAIN = false;
    bf16_t* gla; bf16_t* nq; bf16_t* kv; size_t kv_stride; float* rg; const float* tab;
    __device__ __forceinline__ void operator()(const f32x4 (&acc)[2][2][4][2], const Unit& u, int wr, int wc, int fr, int fq) const {
        const int pn = u.pn, row0 = u.pm * BM + wr * 64 + fr, c8 = wc * 32 + 8 * fq;
        if (pn < 6) {
#pragma unroll
            for (int ai = 0; ai < 2; ++ai)
#pragma unroll
                for (int m = 0; m < 4; ++m) { bf16_t* rowp = gla + (size_t)(row0 + ai * HALF + m * 16) * 1536 + pn * 256 + c8;
#pragma unroll
                    for (int bj = 0; bj < 2; ++bj) { const f32x4 v0 = acc[ai][bj][m][0], v1 = acc[ai][bj][m][1];
                        u32x4 w; w.x = cvt_pk_bf16(v0[0], v0[1]); w.y = cvt_pk_bf16(v0[2], v0[3]); w.z = cvt_pk_bf16(v1[0], v1[1]); w.w = cvt_pk_bf16(v1[2], v1[3]);
                        *(u32x4*)(rowp + bj * HALF) = w; } }
        } else if (pn == 14) {
            if (wc == 0) {
#pragma unroll
                for (int ai = 0; ai < 2; ++ai)
#pragma unroll
                    for (int m = 0; m < 4; ++m) { float* rp = rg + (size_t)(row0 + ai * HALF + m * 16) * 32 + 8 * fq;
                        *(f32x4*)rp = acc[ai][0][m][0]; *(f32x4*)(rp + 4) = acc[ai][0][m][1]; }
            }
        } else {
            const int b = (u.pm * BM) / SEQ, s0 = (u.pm * BM) % SEQ + wr * 64 + fr;
            bf16_t* T; int NH, hbase; bool rope;
            if (pn <= 7) { T = nq; NH = 4; hbase = 2 * (pn - 6); rope = true; }
            else { const int t = pn - 8; T = kv + (size_t)t * kv_stride; NH = 2; hbase = 0; rope = (t & 1) == 0; }
#pragma unroll
            for (int bj = 0; bj < 2; ++bj) { bf16_t* hb = T + (size_t)(b * NH + hbase + bj) * SEQ * 128;
#pragma unroll
                for (int ai = 0; ai < 2; ++ai)
#pragma unroll
                    for (int m = 0; m < 4; ++m) { const int s = s0 + ai * HALF + m * 16; const f32x4 v0 = acc[ai][bj][m][0], v1 = acc[ai][bj][m][1];
                        if (rope) { const int d0 = 16 * wc + 4 * fq; const f32x4* tp = (const f32x4*)(tab + ((size_t)(row0 + ai * HALF + m * 16) * 64 + d0) * 2);
                            const f32x4 ca = tp[0], cb = tp[1];
                            u32x2 w1, w2;
                            w1.x = cvt_pk_bf16(v0[0] * ca[0] - v1[0] * ca[1], v0[1] * ca[2] - v1[1] * ca[3]);
                            w1.y = cvt_pk_bf16(v0[2] * cb[0] - v1[2] * cb[1], v0[3] * cb[2] - v1[3] * cb[3]);
                            w2.x = cvt_pk_bf16(v1[0] * ca[0] + v0[0] * ca[1], v1[1] * ca[2] + v0[1] * ca[3]);
                            w2.y = cvt_pk_bf16(v1[2] * cb[0] + v0[2] * cb[1], v1[3] * cb[2] + v0[3] * cb[3]);
                            *(u32x2*)(hb + (size_t)s * 128 + d0) = w1; *(u32x2*)(hb + (size_t)s * 128 + 64 + d0) = w2;
                        } else { u32x4 w; w.x = cvt_pk_bf16(v0[0], v0[1]); w.y = cvt_pk_bf16(v0[2], v0[3]); w.z = cvt_pk_bf16(v1[0], v1[1]); w.w = cvt_pk_bf16(v1[2], v1[3]);
                            *(u32x4*)(hb + (size_t)s * 128 + c8) = w; } } }
        }
    }
};
template <int ACT> struct EpiActBf16 {
    static constexpr bool PERM = true, AFTER_DRAIN = false;
    bf16_t* O; int ldc; const float* bias;
    __device__ __forceinline__ float act(float x) const {
        if (ACT == 1) { const float u2 = 1.5957691216f * (x + 0.044715f * x * x * x); return x / (1.0f + __expf(-u2)); }
        else { const float r = fmaxf(x, 0.f); return r * r; } }
    __device__ __forceinline__ void operator()(const f32x4 (&acc)[2][2][4][2], const Unit& u, int wr, int wc, int fr, int fq) const {
        const int row0 = u.pm * BM + wr * 64 + fr, col0 = u.pn * BM + wc * 32 + 8 * fq;
        f32x4 bv[2][2];
#pragma unroll
        for (int bj = 0; bj < 2; ++bj)
#pragma unroll
            for (int n = 0; n < 2; ++n) bv[bj][n] = bias ? *(const f32x4*)(bias + col0 + bj * HALF + 4 * n) : (f32x4){0.f, 0.f, 0.f, 0.f};
#pragma unroll
        for (int ai = 0; ai < 2; ++ai)
#pragma unroll
            for (int m = 0; m < 4; ++m) { bf16_t* rowp = O + (size_t)(row0 + ai * HALF + m * 16) * ldc + col0;
#pragma unroll
                for (int bj = 0; bj < 2; ++bj) { const f32x4 v0 = acc[ai][bj][m][0] + bv[bj][0], v1 = acc[ai][bj][m][1] + bv[bj][1];
                    u32x4 w; w.x = cvt_pk_bf16(act(v0[0]), act(v0[1])); w.y = cvt_pk_bf16(act(v0[2]), act(v0[3])); w.z = cvt_pk_bf16(act(v1[0]), act(v1[1])); w.w = cvt_pk_bf16(act(v1[2]), act(v1[3]));
                    *(u32x4*)(rowp + bj * HALF) = w; } }
    }
};
struct EpiResid {
    static constexpr bool PERM = false, AFTER_DRAIN = false;
    const float* base; float* out; const float* gate;
    __device__ __forceinline__ void operator()(const f32x4 (&acc)[2][2][4][2], const Unit& u, int wr, int wc, int fr, int fq) const {
        const int row0 = u.pm * BM + wr * 64 + fr, col0 = u.pn * BM + wc * 32 + 4 * fq; const int b = (u.pm * BM) / SEQ;
        f32x4 gv[2][2];
#pragma unroll
        for (int bj = 0; bj < 2; ++bj)
#pragma unroll
            for (int n = 0; n < 2; ++n) gv[bj][n] = *(const f32x4*)(gate + (size_t)b * NMOD + col0 + bj * HALF + n * 16);
#pragma unroll
        for (int ai = 0; ai < 2; ++ai)
#pragma unroll
            for (int m = 0; m < 4; ++m) { const size_t off = (size_t)(row0 + ai * HALF + m * 16) * DM + col0;
#pragma unroll
                for (int bj = 0; bj < 2; ++bj)
#pragma unroll
                    for (int n = 0; n < 2; ++n) { const f32x4 bs = *(const f32x4*)(base + off + bj * HALF + n * 16);
                        *(f32x4*)(out + off + bj * HALF + n * 16) = bs + gv[bj][n] * acc[ai][bj][m][n]; } }
    }
};
template <class Epi, class Sched, bool ALIGN_EPI = false, bool SP2 = false>
__device__ __forceinline__ void gemm_phase(PG8_LAS unsigned char* lds, const Gemm g, const Sched& S, const Epi& E) {
    int tid = threadIdx.x; asm volatile("" : "+v"(tid)); const int wid = __builtin_amdgcn_readfirstlane(tid >> 6), lane = tid & 63, wr = wid >> 2, wc = wid & 3, fr = lane & 15, fq = lane >> 4;
    const int K = g.K, nt = K / BK;
    unsigned voffA[2], voffB[2];
#pragma unroll
    for (int i = 0; i < 2; ++i) { int R, C; stage_rc(tid * 16 + i * 8192, R, C); const int Rb = Epi::PERM ? ((R & ~31) + perm32(R & 31)) : R;
        voffA[i] = (unsigned)(R * g.lda + C) * 2u; voffB[i] = (unsigned)(Rb * K + C) * 2u; }
    const size_t kstep = (size_t)(BK * 2);
    const size_t hstepB = (size_t)HALF * K * 2, hstepA = (size_t)HALF * g.lda * 2;
    const size_t tstepB = 2 * hstepB, tstepA = 2 * hstepA;
    const unsigned ldsw = (unsigned)wid * 1024u;
    const int aoff = lds_byte(wr * 64 + fr, fq * 8), boff = lds_byte(wc * 32 + fr, fq * 8);
#define PG8_SA(b, h) (((b) * 2 + (h)) * HTB)
#define PG8_SB(b, h) ((4 + (b) * 2 + (h)) * HTB)
#define PG8_STAGE(bufoff, gbase, voff) do { _Pragma("unroll") for (int _i = 0; _i < 2; ++_i) \
        __builtin_amdgcn_global_load_lds((const unsigned*)((const char*)(gbase) + (voff)[_i]), (PG8_LAS unsigned*)(lds + (bufoff) + ldsw + _i * 8192), 16, 0, 0); } while (0)
#define PG8_LDA(dst, b, h) do { _Pragma("unroll") for (int m = 0; m < 4; ++m) _Pragma("unroll") for (int k = 0; k < 2; ++k) dst[m][k] = *(const PG8_LAS bf16x8*)(lds + PG8_SA(b, h) + aoff + m * 2048 + k * 1024); } while (0)
#define PG8_LDB(dst, b, h) do { _Pragma("unroll") for (int n = 0; n < 2; ++n) _Pragma("unroll") for (int k = 0; k < 2; ++k) dst[n][k] = *(const PG8_LAS bf16x8*)(lds + PG8_SB(b, h) + boff + n * 2048 + k * 1024); } while (0)
#define PG8_MMA(ai, bj, At, Bt) do { __builtin_amdgcn_s_setprio(1); _Pragma("unroll") for (int m = 0; m < 4; ++m) _Pragma("unroll") for (int n = 0; n < 2; ++n) _Pragma("unroll") for (int k = 0; k < 2; ++k) \
        acc[ai][bj][m][n] = __builtin_amdgcn_mfma_f32_16x16x32_bf16(Bt[n][k], At[m][k], acc[ai][bj][m][n], 0, 0, 0); __builtin_amdgcn_s_setprio(0); } while (0)
#define PG8_WAIT_V(n) asm volatile("s_waitcnt vmcnt(" #n ")" ::: "memory")
#define PG8_WAIT_L(n) asm volatile("s_waitcnt lgkmcnt(" #n ")" ::: "memory")
#define PG8_BAR __builtin_amdgcn_s_barrier()
#define PG8_SCHED __builtin_amdgcn_sched_barrier(0)
    Unit cur, nxt; int ui = 0;
    if (!S.next(0, cur)) return;
    f32x4 acc[2][2][4][2];
#pragma unroll
    for (int a = 0; a < 2; ++a)
#pragma unroll
        for (int b = 0; b < 2; ++b)
#pragma unroll
            for (int m = 0; m < 4; ++m)
#pragma unroll
                for (int n = 0; n < 2; ++n) acc[a][b][m][n] = (f32x4){0.f, 0.f, 0.f, 0.f};
    bf16x8 At[4][2], B0[2][2], B1[2][2];
    const char* cA = (const char*)g.A + (size_t)cur.pm * tstepA; const char* cB = (const char*)g.Bt + (size_t)cur.pn * tstepB;
    S.a_ready(cur);
    if constexpr (SP2) {
        PG8_STAGE(PG8_SB(0, 0), cB, voffB); PG8_STAGE(PG8_SB(0, 1), cB + hstepB, voffB); PG8_STAGE(PG8_SA(0, 0), cA, voffA); PG8_STAGE(PG8_SA(0, 1), cA + hstepA, voffA);
        if (wr == 1) PG8_BAR;
        PG8_WAIT_V(2); PG8_BAR;
        PG8_STAGE(PG8_SB(1, 0), cB + kstep, voffB); PG8_STAGE(PG8_SA(1, 0), cA + kstep, voffA); PG8_STAGE(PG8_SB(1, 1), cB + hstepB + kstep, voffB);
        PG8_WAIT_V(6); PG8_BAR;
    } else {
        PG8_STAGE(PG8_SB(0, 0), cB, voffB); PG8_STAGE(PG8_SA(0, 0), cA, voffA); PG8_STAGE(PG8_SB(0, 1), cB + hstepB, voffB); PG8_STAGE(PG8_SA(0, 1), cA + hstepA, voffA);
        if (wr == 1) PG8_BAR;
        PG8_WAIT_V(4); PG8_BAR;
        PG8_STAGE(PG8_SB(1, 0), cB + kstep, voffB); PG8_STAGE(PG8_SA(1, 0), cA + kstep, voffA); PG8_STAGE(PG8_SB(1, 1), cB + hstepB + kstep, voffB);
        PG8_WAIT_V(6); PG8_BAR;
    }
    for (;;) {
        const bool has_next = S.next(ui + 1, nxt);
        const char* nA = has_next ? (const char*)g.A + (size_t)nxt.pm * tstepA : cA; const char* nB = has_next ? (const char*)g.Bt + (size_t)nxt.pn * tstepB : cB;
        for (int t = 0; t < nt; t += 2) {
            const bool last = (t == nt - 2);
            const char* a1 = cA + (size_t)(t + 1) * kstep;
            const char* a2 = last ? nA : cA + (size_t)(t + 2) * kstep; const char* b2 = last ? nB : cB + (size_t)(t + 2) * kstep;
            const char* a3 = a2 + kstep; const char* b3 = b2 + kstep;
            if (last && has_next) S.a_ready(nxt);
            if constexpr (SP2) {
            PG8_LDB(B0, 0, 0); PG8_LDB(B1, 0, 1); PG8_SCHED; PG8_LDA(At, 0, 0); PG8_STAGE(PG8_SA(1, 1), a1 + hstepA, voffA);
            PG8_WAIT_V(8); PG8_WAIT_L(0); PG8_BAR; PG8_MMA(0, 0, At, B0); PG8_MMA(0, 1, At, B1); PG8_BAR; PG8_SCHED;
            PG8_LDA(At, 0, 1); PG8_STAGE(PG8_SB(0, 0), b2, voffB); PG8_STAGE(PG8_SB(0, 1), b2 + hstepB, voffB); PG8_STAGE(PG8_SA(0, 0), a2, voffA);
            PG8_WAIT_V(8); PG8_WAIT_L(0); PG8_BAR; PG8_MMA(1, 0, At, B0); PG8_MMA(1, 1, At, B1); PG8_BAR; PG8_SCHED;
            PG8_LDB(B0, 1, 0); PG8_LDB(B1, 1, 1); PG8_SCHED; PG8_LDA(At, 1, 0); PG8_STAGE(PG8_SA(0, 1), a2 + hstepA, voffA);
            PG8_WAIT_V(8); PG8_WAIT_L(0); PG8_BAR; PG8_MMA(0, 0, At, B0); PG8_MMA(0, 1, At, B1); PG8_BAR; PG8_SCHED;
            PG8_LDA(At, 1, 1); PG8_STAGE(PG8_SB(1, 0), b3, voffB); PG8_STAGE(PG8_SB(1, 1), b3 + hstepB, voffB); PG8_STAGE(PG8_SA(1, 0), a3, voffA);
            PG8_WAIT_V(8); PG8_WAIT_L(0); PG8_BAR; PG8_MMA(1, 0, At, B0); PG8_MMA(1, 1, At, B1); PG8_BAR; PG8_SCHED;
            } else {
            PG8_LDB(B0, 0, 0); PG8_SCHED; PG8_LDA(At, 0, 0); PG8_STAGE(PG8_SA(1, 1), a1 + hstepA, voffA);
            PG8_WAIT_L(8); PG8_BAR; PG8_WAIT_L(0); PG8_MMA(0, 0, At, B0); PG8_BAR; PG8_SCHED;
            PG8_LDB(B1, 0, 1); PG8_STAGE(PG8_SB(0, 0), b2, voffB);
            PG8_BAR; PG8_WAIT_L(0); PG8_MMA(0, 1, At, B1); PG8_BAR;
            PG8_LDA(At, 0, 1); PG8_STAGE(PG8_SA(0, 0), a2, voffA);
            PG8_BAR; PG8_WAIT_L(0); PG8_MMA(1, 0, At, B0); PG8_BAR; PG8_SCHED;
            PG8_STAGE(PG8_SB(0, 1), b2 + hstepB, voffB);
            PG8_WAIT_V(6); PG8_BAR; PG8_MMA(1, 1, At, B1); PG8_BAR;
            PG8_LDB(B0, 1, 0); PG8_SCHED; PG8_LDA(At, 1, 0); PG8_STAGE(PG8_SA(0, 1), a2 + hstepA, voffA);
            PG8_WAIT_L(8); PG8_BAR; PG8_WAIT_L(0); PG8_MMA(0, 0, At, B0); PG8_BAR; PG8_SCHED;
            PG8_LDB(B1, 1, 1); PG8_STAGE(PG8_SB(1, 0), b3, voffB);
            PG8_BAR; PG8_WAIT_L(0); PG8_MMA(0, 1, At, B1); PG8_BAR;
            PG8_LDA(At, 1, 1); PG8_STAGE(PG8_SA(1, 0), a3, voffA);
            PG8_BAR; PG8_WAIT_L(0); PG8_MMA(1, 0, At, B0); PG8_BAR; PG8_SCHED;
            PG8_STAGE(PG8_SB(1, 1), b3 + hstepB, voffB);
            PG8_WAIT_V(6); PG8_BAR; PG8_MMA(1, 1, At, B1); PG8_BAR;
            }
        }
        if constexpr (ALIGN_EPI) { if (wr == 0) PG8_BAR; }
        if constexpr (!Epi::AFTER_DRAIN) { E(acc, cur, wr, wc, fr, fq); S.done(cur); }
        if (!has_next) break;
#pragma unroll
        for (int a = 0; a < 2; ++a)
#pragma unroll
            for (int b = 0; b < 2; ++b)
#pragma unroll
                for (int m = 0; m < 4; ++m)
#pragma unroll
                    for (int n = 0; n < 2; ++n) acc[a][b][m][n] = (f32x4){0.f, 0.f, 0.f, 0.f};
        cur = nxt; cA = nA; cB = nB; ++ui;
        if constexpr (ALIGN_EPI) { if (wr == 1) PG8_BAR; }
    }
    PG8_WAIT_V(0);
    if constexpr (!ALIGN_EPI) { if (wr == 0) PG8_BAR; }
    PG8_BAR;
    if constexpr (Epi::AFTER_DRAIN) { E.fused(acc, cur, wr, wc, fr, fq, lds, wid, lane); S.done(cur); }
#undef PG8_SA
#undef PG8_SB
#undef PG8_STAGE
#undef PG8_LDA
#undef PG8_LDB
#undef PG8_MMA
#undef PG8_WAIT_V
#undef PG8_WAIT_L
#undef PG8_BAR
#undef PG8_SCHED
}
}
namespace nsa {
typedef unsigned short bf16_t;
typedef short bf16x8 __attribute__((ext_vector_type(8)));
typedef short s16x4 __attribute__((ext_vector_type(4)));
typedef float f32x16 __attribute__((ext_vector_type(16)));
typedef float f32x4 __attribute__((ext_vector_type(4)));
typedef unsigned u32x4 __attribute__((ext_vector_type(4)));
constexpr int D = 128, KVBLK = 64, QBLK = 32, UROWS = 128;
constexpr float SCALE = 0.08838834764831845f;
constexpr int SHM_V = KVBLK * D * 2, SHM_K = KVBLK * D * 2;
constexpr int L_V = 0, L_K = 2 * SHM_V, L_WS = 2 * SHM_V + 2 * SHM_K, L_IMP = L_WS + 8 * 64 * 4, L_QF = L_IMP  , L_SELB = L_IMP + 2 * UROWS * 32 * 4, L_END = L_QF + 8 * 8192;
#define KSWZ(row, colB) ((row) * 256 + ((colB) ^ (((row) & 7) << 4)))
#define SBAR() __builtin_amdgcn_sched_barrier(0)
__device__ __forceinline__ int v_st(int k, int c) { const int kk = (k & ~0xC) | ((k & 4) << 1) | ((k & 8) >> 1); return ((kk >> 3) * 4 + (c >> 5)) * 512 + ((kk & 7) * 32 + (c & 31)) * 2; }
__device__ __forceinline__ int v_rd_base(int lane) { return ((lane & 3) << 3) | (((lane >> 2) & 3) << 6) | (((lane >> 4) & 1) << 5) | (((lane >> 5) & 1) << 8); }
constexpr int v_rd_off(int d0, int ks, int half) { return d0 * 512 + ks * 4096 + half * 2048; }
__device__ __forceinline__ int crow(int r, int hi) { return (r & 3) + 8 * (r >> 2) + 4 * hi; }
__device__ __forceinline__ unsigned cvtpk(float lo, float hi) { unsigned r; asm volatile("v_cvt_pk_bf16_f32 %0, %1, %2" : "=v"(r) : "v"(lo), "v"(hi)); return r; }
__device__ __forceinline__ void mask_tile(f32x16& p0, f32x16& p1, int dq, unsigned W) {
    const float NEG = -__builtin_inff();
#pragma unroll
    for (int r = 0; r < 16; ++r) { const int c = (r & 3) + 8 * (r >> 2);
        if ((unsigned)(dq - c) >= W) p0[r] = NEG;
        if ((unsigned)(dq - c - 32) >= W) p1[r] = NEG; }
}
__device__ __forceinline__ void partialSM(f32x16& p0, f32x16& p1, float& m_reg, float& mn, float& alpha) {
    float pmax = p0[0];
#pragma unroll
    for (int r = 1; r < 16; ++r) pmax = fmaxf(pmax, p0[r]);
#pragma unroll
    for (int r = 0; r < 16; ++r) pmax = fmaxf(pmax, p1[r]);
    { auto rr = __builtin_amdgcn_permlane32_swap(__float_as_uint(pmax), __float_as_uint(pmax), false, false);
      pmax = fmaxf(__uint_as_float(rr[0]), __uint_as_float(rr[1])); }
    constexpr float C2 = 1.4426950408889634f * SCALE;
    if (__builtin_expect(__all(pmax <= m_reg), 0)) { mn = m_reg; alpha = 1.f; }
    else { mn = fmaxf(m_reg, pmax); alpha = __builtin_amdgcn_exp2f((m_reg - mn) * C2); m_reg = mn; }
    const float mnL = -mn * C2;
#pragma unroll
    for (int r = 0; r < 16; ++r) p0[r] = fmaf(p0[r], C2, mnL);
#pragma unroll
    for (int r = 0; r < 16; ++r) p1[r] = fmaf(p1[r], C2, mnL);
#pragma unroll
    for (int r = 0; r < 16; ++r) p0[r] = __builtin_amdgcn_exp2f(p0[r]);
}
#define PK4(P, B_, OUT) do { unsigned a0 = cvtpk(P[B_+0], P[B_+1]), a1 = cvtpk(P[B_+2], P[B_+3]);                          \
        unsigned b0 = cvtpk(P[B_+4], P[B_+5]), b1 = cvtpk(P[B_+6], P[B_+7]);                                             \
        auto r0 = __builtin_amdgcn_permlane32_swap(a0, b0, false, false); auto r1 = __builtin_amdgcn_permlane32_swap(a1, b1, false, false); \
        u32x4 w = {r0[0], r1[0], r0[1], r1[1]}; OUT = *reinterpret_cast<bf16x8*>(&w); } while (0)
__device__ __forceinline__ void finishSM(f32x16& p0, f32x16& p1, float alpha, float& l_reg, bf16x8& pa0, bf16x8& pa1, bf16x8& pa2, bf16x8& pa3) {
#pragma unroll
    for (int r = 0; r < 16; ++r) p1[r] = __builtin_amdgcn_exp2f(p1[r]);
    float ps = 0;
#pragma unroll
    for (int r = 0; r < 16; ++r) ps += p0[r];
#pragma unroll
    for (int r = 0; r < 16; ++r) ps += p1[r];
    { auto rr = __builtin_amdgcn_permlane32_swap(__float_as_uint(ps), __float_as_uint(ps), false, false);
      ps = __uint_as_float(rr[0]) + __uint_as_float(rr[1]); }
    l_reg = l_reg * alpha + ps;
    PK4(p0, 0, pa0); PK4(p0, 8, pa1); PK4(p1, 0, pa2); PK4(p1, 8, pa3);
}
template <int KB>
__device__ __forceinline__ void qkt(f32x16& p0, f32x16& p1, const char* K_lds, int r32, int hi, const bf16x8* qr) {
    p0 = f32x16{}; p1 = f32x16{};
    const char* kb[4];
#pragma unroll
    for (int dd = 0; dd < 4; ++dd) kb[dd] = K_lds + KB * SHM_K + KSWZ(r32, (dd * 16 + hi * 8) * 2);
#pragma unroll
    for (int d0 = 0; d0 < 8; ++d0) { const char* a = kb[d0 & 3] + (d0 >> 2) * 128;
        bf16x8 b0 = *reinterpret_cast<const bf16x8*>(a);
        bf16x8 b1 = *reinterpret_cast<const bf16x8*>(a + 32 * 256);
        p0 = __builtin_amdgcn_mfma_f32_32x32x16_bf16(b0, qr[d0], p0, 0, 0, 0);
        p1 = __builtin_amdgcn_mfma_f32_32x32x16_bf16(b1, qr[d0], p1, 0, 0, 0); }
}
template <int KB>
__device__ __forceinline__ void qkt2(f32x16& p0, f32x16& p1, const char* K_lds, int r32, int hi, const char* qf) {
    p0 = f32x16{}; p1 = f32x16{};
    const char* kb[4];
#pragma unroll
    for (int dd = 0; dd < 4; ++dd) kb[dd] = K_lds + KB * SHM_K + KSWZ(r32, (dd * 16 + hi * 8) * 2);
#pragma unroll
    for (int d0 = 0; d0 < 8; ++d0) { const char* a = kb[d0 & 3] + (d0 >> 2) * 128;
        bf16x8 b0 = *reinterpret_cast<const bf16x8*>(a);
        bf16x8 b1 = *reinterpret_cast<const bf16x8*>(a + 32 * 256);
        const bf16x8 q = *reinterpret_cast<const bf16x8*>(qf + d0 * 1024);
        p0 = __builtin_amdgcn_mfma_f32_32x32x16_bf16(b0, q, p0, 0, 0, 0);
        p1 = __builtin_amdgcn_mfma_f32_32x32x16_bf16(b1, q, p1, 0, 0, 0); }
}
template <int VB>
__device__ __forceinline__ void pv_tile(f32x16* o, int vb0, bf16x8 pa0, bf16x8 pa1, bf16x8 pa2, bf16x8 pa3) {
#define TRRD(dst, off) asm volatile("ds_read_b64_tr_b16 %0, %1 offset:%2" : "=&v"(dst) : "v"(vb0), "i"(off) : "memory")
#define PV_D0(d0) do { s16x4 l0, l1, l2, l3, h0, h1, h2, h3; constexpr int b_ = VB * SHM_V + v_rd_off(d0, 0, 0); \
        TRRD(l0, b_); TRRD(h0, b_ + 2048); TRRD(l1, b_ + 4096); TRRD(h1, b_ + 6144); TRRD(l2, b_ + 8192); TRRD(h2, b_ + 10240); TRRD(l3, b_ + 12288); TRRD(h3, b_ + 14336); \
        asm volatile("s_waitcnt lgkmcnt(0)" ::: "memory"); SBAR();   \
        o[d0] = __builtin_amdgcn_mfma_f32_32x32x16_bf16(pa0, (bf16x8){l0[0], l0[1], l0[2], l0[3], h0[0], h0[1], h0[2], h0[3]}, o[d0], 0, 0, 0);   \
        o[d0] = __builtin_amdgcn_mfma_f32_32x32x16_bf16(pa1, (bf16x8){l1[0], l1[1], l1[2], l1[3], h1[0], h1[1], h1[2], h1[3]}, o[d0], 0, 0, 0);   \
        o[d0] = __builtin_amdgcn_mfma_f32_32x32x16_bf16(pa2, (bf16x8){l2[0], l2[1], l2[2], l2[3], h2[0], h2[1], h2[2], h2[3]}, o[d0], 0, 0, 0);   \
        o[d0] = __builtin_amdgcn_mfma_f32_32x32x16_bf16(pa3, (bf16x8){l3[0], l3[1], l3[2], l3[3], h3[0], h3[1], h3[2], h3[3]}, o[d0], 0, 0, 0); } while (0)
    PV_D0(0); PV_D0(1); PV_D0(2); PV_D0(3);
#undef PV_D0
#undef TRRD
}
__device__ __forceinline__ int swa_jlo(int P0, int W) { const int lowk = P0 - W + 1; return lowk > 0 ? lowk / KVBLK : 0; }
#define ROW(p, k0, rr) ((p) + (size_t)((k0) + (rr)) * D + sc)
#define VMW() asm volatile("s_waitcnt vmcnt(0)" ::: "memory")
#define SLOAD_H(Kp, Vp, k0) do { st_v0 = *(const bf16x8*)ROW(Vp, k0, sr); st_v1 = *(const bf16x8*)ROW(Vp, k0, 32 + sr); \
                                 st_k0 = *(const bf16x8*)ROW(Kp, k0, sr); st_k1 = *(const bf16x8*)ROW(Kp, k0, 32 + sr); } while (0)
#define SWRITE_HK(bf) do { *(bf16x8*)(K_lds + (bf) * SHM_K + kws) = st_k0; *(bf16x8*)(K_lds + (bf) * SHM_K + kws + 32 * 256) = st_k1; } while (0)
#define SWRITE_HV(bf) do { *(bf16x8*)(V_lds + (bf) * SHM_V + vst0) = st_v0; *(bf16x8*)(V_lds + (bf) * SHM_V + vst1) = st_v1; } while (0)
#define SWRITE_H(bf) do { SWRITE_HV(bf); SWRITE_HK(bf); } while (0)
#define STORE_O() do { int t3_ = threadIdx.x; asm volatile("" : "+v"(t3_)); float* li_l = (float*)(lds + L_WS) + (t3_ >> 6) * 64;                   \
        if (hi == 0) li_l[r32] = l_inv; asm volatile("s_waitcnt lgkmcnt(0)" ::: "memory"); float rli[16];                       \
        __attribute__((address_space(1))) bf16_t* Ob_ = (__attribute__((address_space(1))) bf16_t*)Ow; asm volatile("" : "+v"(Ob_));           \
        _Pragma("unroll") for (int r = 0; r < 16; ++r) rli[r] = li_l[crow(r, hi)];                                                         \
        _Pragma("unroll") for (int r = 0; r < 16; ++r) { const int orow = crow(r, hi);                                                     \
            _Pragma("unroll") for (int d0 = 0; d0 < 4; ++d0) { const float v = o[d0][r] * rli[r]; const float vn = __shfl_xor(v, 1);       \
                if ((r32 & 1) == 0) *(__attribute__((address_space(1))) unsigned*)(Ob_ + (size_t)orow * opitch + d0 * 32 + r32) = cvtpk(v, vn); } } } while (0)

template <bool SEL>
__device__ __forceinline__ void attn_branch(const bf16_t* Qw, const bf16_t* Kh, const bf16_t* Vh, bf16_t* Ow, int opitch, int P0, int qrel, int W, const unsigned* selg, char* lds) {
    int tid = threadIdx.x; asm volatile("" : "+v"(tid));
    const int lane = tid & 63, r32 = lane & 31, hi = lane >> 5;
    const int j_lo = SEL ? 0 : swa_jlo(P0, W);
    const int j_hi = (P0 + UROWS - 1) / KVBLK + 1;
    const int NT = j_hi - j_lo;
    const int qlo = P0 + qrel, qm = qlo + r32 - 4 * hi;
    char* V_lds = lds + L_V; char* K_lds = lds + L_K;
    unsigned selbits = 0xffffffffu; if (SEL) selbits = selg[qrel + r32];
    float m_reg = -1e30f, l_reg = 0; f32x16 o[4] = {};
    const int sr = tid >> 4, sc = (tid & 15) * 8, vst0 = v_st(sr, sc), vst1 = v_st(32 + sr, sc), kws = KSWZ(sr, sc * 2);
    const int vb0 = (int)(uintptr_t)V_lds + v_rd_base(lane);
    char* qf = lds + L_QF + (tid >> 6) * 8192 + lane * 16;
#pragma unroll
    for (int d0 = 0; d0 < 8; ++d0) *(bf16x8*)(qf + d0 * 1024) = *(const bf16x8*)(Qw + (size_t)r32 * D + d0 * 16 + hi * 8);
    bf16x8 st_v0, st_v1, st_k0, st_k1;
#define RESC(a) do { if (__any((a) < 1.f)) { int t2_ = threadIdx.x; asm volatile("" : "+v"(t2_));     \
                     float* al2_ = (float*)(lds + L_WS) + (t2_ >> 6) * 64 + 32; const int h2_ = (t2_ >> 5) & 1;                                    \
                     if (h2_ == 0) al2_[t2_ & 31] = (a); asm volatile("s_waitcnt lgkmcnt(0)" ::: "memory");              \
                     _Pragma("unroll") for (int d_ = 0; d_ < 4; ++d_) _Pragma("unroll") for (int r = 0; r < 16; ++r) o[d_][r] *= al2_[crow(r, h2_)]; } } while (0)
#define KBASE(t) ((j_lo + (t)) * KVBLK)
#define MASKT(P0_, P1_, t) do { const int kb_ = KBASE(t); if (kb_ + KVBLK - 1 > qlo || kb_ <= qlo + QBLK - 1 - W) mask_tile(P0_, P1_, qm - kb_, (unsigned)W);  \
        if (SEL) { const bool off_ = ((selbits >> (j_lo + (t))) & 1u) == 0u; const float NEG_ = -__builtin_inff();                                          \
            _Pragma("unroll") for (int r = 0; r < 16; ++r) { P0_[r] = off_ ? NEG_ : P0_[r]; P1_[r] = off_ ? NEG_ : P1_[r]; } } } while (0)
    f32x16 p0, p1; float mn, al; bf16x8 pa0, pa1, pa2, pa3;
    SLOAD_H(Kh, Vh, KBASE(0)); VMW(); SWRITE_H(0);
    if (NT > 1) SLOAD_H(Kh, Vh, KBASE(1));
    __syncthreads();
    for (int t = 0; t < NT; ++t) { const int bo = t & 1;
        SBAR(); qkt2<0>(p0, p1, K_lds + bo * SHM_K, r32, hi, qf);
        MASKT(p0, p1, t); partialSM(p0, p1, m_reg, mn, al); RESC(al);
        finishSM(p0, p1, al, l_reg, pa0, pa1, pa2, pa3); SBAR();
        pv_tile<0>(o, vb0 + bo * SHM_V, pa0, pa1, pa2, pa3); SBAR();
        if (t + 1 < NT) { VMW(); SWRITE_H(bo ^ 1); if (t + 2 < NT) SLOAD_H(Kh, Vh, KBASE(t + 2)); }
        __syncthreads(); }
    const float l_inv = __builtin_amdgcn_rcpf(l_reg);
    STORE_O();
    __syncthreads();
#undef RESC
#undef KBASE
#undef MASKT
#undef HALF_STEP
}

__device__ __forceinline__ void cmp_branch(const bf16_t* Qw, const bf16_t* Kc, const bf16_t* Vc, bf16_t* Ow, int opitch, int P0, int qrel, int g, unsigned* selg, char* lds) {
    int tid = threadIdx.x; asm volatile("" : "+v"(tid));
    const int lane = tid & 63, r32 = lane & 31, hi = lane >> 5;
    char* V_lds = lds + L_V; char* K_lds = lds + L_K;
    float* imp = (float*)(lds + L_IMP); unsigned* selb = (unsigned*)(lds + L_SELB);
    const int sr = tid >> 4, sc = (tid & 15) * 8, vst0 = v_st(sr, sc), vst1 = v_st(32 + sr, sc), kws = KSWZ(sr, sc * 2);
    const int vb0 = (int)(uintptr_t)V_lds + v_rd_base(lane);
    bf16x8 qr[8];
#pragma unroll
    for (int d0 = 0; d0 < 8; ++d0) qr[d0] = *(const bf16x8*)(Qw + (size_t)r32 * D + d0 * 16 + hi * 8);
    bf16x8 st_v0, st_v1, st_k0, st_k1;
    SLOAD_H(Kc, Vc, 0); VMW(); SWRITE_H(0); SBAR();
    SLOAD_H(Kc, Vc, 64); VMW(); SWRITE_H(1);
    __syncthreads();
    f32x16 pA0, pA1, pB0, pB1;
    qkt<0>(pA0, pA1, K_lds, r32, hi, qr); SBAR(); qkt<1>(pB0, pB1, K_lds, r32, hi, qr); SBAR();
    const int tpos = P0 + qrel + r32, nmax = (tpos - 31) >> 4;
    const float NEG = -__builtin_inff();
    const int nm = nmax - 4 * hi;
#pragma unroll
    for (int r = 0; r < 16; ++r) { const int c = (r & 3) + 8 * (r >> 2);
        if (c > nm) pA0[r] = NEG; if (c + 32 > nm) pA1[r] = NEG; if (c + 64 > nm) pB0[r] = NEG; if (c + 96 > nm) pB1[r] = NEG; }
    float pmax = NEG;
#pragma unroll
    for (int r = 0; r < 16; ++r) pmax = fmaxf(fmaxf(pmax, pA0[r]), fmaxf(pA1[r], fmaxf(pB0[r], pB1[r])));
    { auto rr = __builtin_amdgcn_permlane32_swap(__float_as_uint(pmax), __float_as_uint(pmax), false, false);
      pmax = fmaxf(__uint_as_float(rr[0]), __uint_as_float(rr[1])); }
    constexpr float C2 = 1.4426950408889634f * SCALE;
    const float mnL = -fmaxf(pmax, -1e30f) * C2;
    float ps = 0.f;
#pragma unroll
    for (int r = 0; r < 16; ++r) { pA0[r] = __builtin_amdgcn_exp2f(fmaf(pA0[r], C2, mnL)); pA1[r] = __builtin_amdgcn_exp2f(fmaf(pA1[r], C2, mnL));
        pB0[r] = __builtin_amdgcn_exp2f(fmaf(pB0[r], C2, mnL)); pB1[r] = __builtin_amdgcn_exp2f(fmaf(pB1[r], C2, mnL));
        ps += (pA0[r] + pA1[r]) + (pB0[r] + pB1[r]); }
    { auto rr = __builtin_amdgcn_permlane32_swap(__float_as_uint(ps), __float_as_uint(ps), false, false);
      ps = __uint_as_float(rr[0]) + __uint_as_float(rr[1]); }
    const float l_inv = ps > 0.f ? 1.0f / ps : 0.f; SBAR();
#if !defined(CMP_NO_IMP)
    { float A[16], Bo[16], Bp[16];
#define IMPG(P, T) _Pragma("unroll") for (int rq = 0; rq < 4; ++rq) { const float h3 = 0.5f * P[4 * rq + 3]; A[(T) * 4 + rq] = (P[4 * rq] + P[4 * rq + 1]) + (P[4 * rq + 2] + h3); Bo[(T) * 4 + rq] = h3; }
      IMPG(pA0, 0) IMPG(pA1, 1) IMPG(pB0, 2) IMPG(pB1, 3)
#undef IMPG
#pragma unroll
      for (int i = 0; i < 16; ++i) Bp[i] = __shfl_xor(Bo[i], 32);
      float* dst = imp + ((size_t)g * UROWS + qrel + r32) * 32 + hi;
#pragma unroll
      for (int i = 0; i < 16; ++i) { const float prev = i > 0 ? Bp[i - 1] : 0.f; const float v = (A[i] + (hi ? Bp[i] : prev)) * l_inv; dst[2 * i] = v; } }
#endif
    SBAR(); bf16x8 pa0, pa1, pa2, pa3; f32x16 o[4] = {};
#if !defined(CMP_NO_PV)
    PK4(pA0, 0, pa0); PK4(pA0, 8, pa1); PK4(pA1, 0, pa2); PK4(pA1, 8, pa3); SBAR();
    pv_tile<0>(o, vb0, pa0, pa1, pa2, pa3);
    PK4(pB0, 0, pa0); PK4(pB0, 8, pa1); PK4(pB1, 0, pa2); PK4(pB1, 8, pa3); SBAR();
    pv_tile<1>(o, vb0, pa0, pa1, pa2, pa3); SBAR();
#endif
    STORE_O(); SBAR();
    __syncthreads();
#if !defined(CMP_NO_TOPK)
    { const int token = tid >> 2, sub = tid & 3; const float* i0 = imp + (size_t)token * 32; const float* i1 = imp + (size_t)(UROWS + token) * 32;
      const int bt = (P0 + token) >> 6; float v[32];
#pragma unroll
      for (int i = 0; i < 32; ++i) { const float x = i0[i] + i1[i]; const bool forced = (i == 0) || (i == bt) || (i == bt - 1); v[i] = forced ? 1e30f : (i <= bt ? x : -1e30f); }
      unsigned bits = 0u;
#pragma unroll
      for (int jj = 0; jj < 8; ++jj) { const int j = 4 * jj + sub; const float xj = i0[j] + i1[j]; const bool forced = (j == 0) || (j == bt) || (j == bt - 1);
          const float vj = forced ? 1e30f : (j <= bt ? xj : -1e30f); int cnt = 0;
#pragma unroll
          for (int i = 0; i < 32; ++i) { bool c;
              if ((i >> 2) < jj) c = v[i] >= vj; else if ((i >> 2) > jj) c = v[i] > vj; else c = ((i & 3) < sub) ? (v[i] >= vj) : (v[i] > vj);
              cnt += c ? 1 : 0; }
          if (cnt < 16) bits |= 1u << j;
          SBAR(); }
      bits |= __shfl_xor(bits, 1); bits |= __shfl_xor(bits, 2);
      if (sub == 0) { selb[token] = bits; if (selg) selg[token] = bits; } }
#endif
    asm volatile("s_waitcnt vmcnt(0)" ::: "memory");
    __syncthreads();
}
#undef ROW
#undef SLOAD_H
#undef SWRITE_HK
#undef SWRITE_HV
#undef SWRITE_H
#undef STORE_O
#undef PK4
#undef VMW
#undef SBAR
#undef KSWZ
}
constexpr int NWAVES = 8;
#ifndef MK_N_LAUNCHES
#define MK_N_LAUNCHES 1
#endif
constexpr int N_PHASES = 12;
constexpr int N_LAUNCHES = MK_N_LAUNCHES;
constexpr size_t MiB = 1u << 20;
constexpr size_t WS_CTL = 0, CTL_ZERO_BYTES = 1 * MiB;
constexpr size_t WS_MOD = 256 * 1024;
constexpr size_t WS_PEB = 704 * 1024;
constexpr size_t WS_WIN = 2 * MiB, WS_WO = 10 * MiB, WS_WFF1 = 12 * MiB, WS_WFF2 = 20 * MiB, WS_CKW1 = 28 * MiB, WS_CVW1 = 30 * MiB;
constexpr size_t WS_TAB = 32 * MiB;
constexpr size_t WS_XN = 48 * MiB;
constexpr size_t WS_RG = 112 * MiB;
constexpr size_t WS_HID = 116 * MiB;
constexpr size_t WS_KCMP = 120 * MiB, WS_VCMP = 121 * MiB;
constexpr size_t WS_SEL = 122 * MiB;
constexpr size_t WS_H = 124 * MiB;
constexpr size_t WS_GLA = 124 * MiB;
constexpr size_t WS_NQ = 220 * MiB;
constexpr size_t WS_KV = 252 * MiB, KV_STRIDE_B = 17 * MiB;
constexpr size_t WS_OBR = 380 * MiB, OBR_STRIDE_B = 32 * MiB;
constexpr size_t WS_END = 476 * MiB;
static_assert(WS_KV + 6 * KV_STRIDE_B <= WS_OBR && WS_H + (size_t)MTOK * DFF * 2 <= WS_OBR && WS_MOD + 16 * NMOD * 4 <= WS_PEB && WS_PEB + 2048 <= CTL_ZERO_BYTES, "d_ws map");
constexpr int CW_BAR = 4096;
constexpr int CW_QW = 8192, CW_QS = 8192 + 256;
constexpr int RING_BYTES = 131072, LDSCTL_OFF = 135168, MISC_OFF = LDSCTL_OFF + 320, LDS_BYTES = 147456;
static_assert(nsa::L_END <= LDSCTL_OFF && nsa::L_SELB + 512 <= nsa::L_END, "attention scratch below the LDS control words");

#define GAS __attribute__((address_space(1)))
#define LAS __attribute__((address_space(3)))
typedef unsigned short bf16;
typedef unsigned v4u __attribute__((ext_vector_type(4)));
typedef unsigned v2u __attribute__((ext_vector_type(2)));
typedef float f32x4 __attribute__((ext_vector_type(4)));
typedef GAS unsigned gu32;
#define RLX_AGENT __ATOMIC_RELAXED, __HIP_MEMORY_SCOPE_AGENT
#define LDS_WAIT() asm volatile("s_waitcnt lgkmcnt(0)" ::: "memory")
#define VM_WAIT() asm volatile("s_waitcnt vmcnt(0)" ::: "memory")
__device__ __forceinline__ unsigned f2bf(float f) { unsigned u = __builtin_bit_cast(unsigned, f); return (u + 0x7fffu + ((u >> 16) & 1u)) >> 16; }
__device__ __forceinline__ unsigned pk2(float lo, float hi) { return f2bf(lo) | (f2bf(hi) << 16); }
__device__ __forceinline__ float bf2f(unsigned short u) { return __builtin_bit_cast(float, (unsigned)u << 16); }
__device__ __forceinline__ float bflo(unsigned w) { return __builtin_bit_cast(float, w << 16); }
__device__ __forceinline__ float bfhi(unsigned w) { return __builtin_bit_cast(float, w & 0xffff0000u); }
#define XB_TMO      128
#define XB_XCNT(j)  (256  + 64 * (j))
#define XB_XSUB(j)  (1280 + 64 * (j))
#define XB_XGEN(j)  (2304 + 64 * (j))
#define XB_TOP      3328
#define XB_TOPGEN   3392
#define XCD_BAR_WORDS 3456
#define XB_SPIN_CAP (1u << 18)

__device__ __forceinline__ unsigned xb_ld(unsigned* p)              { return __hip_atomic_load(p, __ATOMIC_RELAXED, __HIP_MEMORY_SCOPE_AGENT); }
__device__ __forceinline__ unsigned xb_add(unsigned* p, unsigned v) { return __hip_atomic_fetch_add(p, v, __ATOMIC_RELAXED, __HIP_MEMORY_SCOPE_AGENT); }
__device__ __forceinline__ unsigned xb_xcc_id() { return (unsigned)__builtin_amdgcn_s_getreg((3 << 11) | 20) & 0xFu; }
#define XB_SPIN(cond, bar) do { unsigned _sp = 0; while (cond) { __builtin_amdgcn_s_sleep(1); \
    if ((++_sp & 255u) == 0u) { if (xb_ld(&(bar)[XB_TMO])) break; if (_sp > XB_SPIN_CAP) { atomicAdd(&(bar)[XB_TMO], 1u); break; } } } } while (0)

struct XcdBarrier {
    unsigned* bar; unsigned x;
    volatile LAS unsigned* st;
};

__device__ __forceinline__ XcdBarrier xcd_barrier_post(unsigned* bar, volatile LAS unsigned* st) {
    XcdBarrier b; b.bar = bar; b.x = xb_xcc_id(); b.st = st;
    if (threadIdx.x == 0) (void)xb_add(&bar[XB_XCNT(b.x)], 1u);
    return b;
}
__device__ __forceinline__ void xcd_barrier_complete(unsigned* bar, unsigned x, unsigned& nloc, unsigned& nx) {
    const unsigned G = gridDim.x * gridDim.y * gridDim.z;
    unsigned sum, cnt, mine, sp = 0u;
    for (;;) {
        sum = 0u; cnt = 0u; mine = 0u;
#pragma unroll
        for (unsigned j = 0; j < 16; ++j) { const unsigned c = xb_ld(&bar[XB_XCNT(j)]); sum += c; cnt += (c > 0u) ? 1u : 0u; mine = (j == x) ? c : mine; }
        if (sum == G) break;
        __builtin_amdgcn_s_sleep(1);
        if ((++sp & 255u) == 0u) { if (xb_ld(&bar[XB_TMO])) break; if (sp > XB_SPIN_CAP) { atomicAdd(&bar[XB_TMO], 1u); break; } }
    }
    nloc = mine > 0u ? mine : 1u; nx = cnt > 0u ? cnt : 1u;
}

__device__ __forceinline__ void xcd_barrier(const XcdBarrier& b) {
    asm volatile("s_waitcnt vmcnt(0)" ::: "memory");
    __syncthreads();
    if (threadIdx.x == 0) {
        unsigned* bar = b.bar;
        __builtin_amdgcn_s_waitcnt(0);
        unsigned nloc = b.st[0], nx = b.st[1];
        if (nloc == 0u) { xcd_barrier_complete(bar, b.x, nloc, nx); b.st[0] = nloc; b.st[1] = nx; }
        const unsigned old = xb_add(&bar[XB_XSUB(b.x)], 1u);
        const unsigned gen = old / nloc;
        if (old + 1u == (gen + 1u) * nloc) {
            __builtin_amdgcn_fence(__ATOMIC_RELEASE, "agent");
            asm volatile("s_waitcnt vmcnt(0)" ::: "memory");
            const unsigned og = xb_add(&bar[XB_TOP], 1u);
            const unsigned tg = og / nx;
            if (og + 1u == (tg + 1u) * nx) xb_add(&bar[XB_TOPGEN], 1u);
            else XB_SPIN(xb_ld(&bar[XB_TOPGEN]) == tg, bar);
            __builtin_amdgcn_fence(__ATOMIC_ACQUIRE, "agent");
            xb_add(&bar[XB_XGEN(b.x)], 1u);
            asm volatile("s_waitcnt vmcnt(0)" ::: "memory");
        } else {
            XB_SPIN(xb_ld(&bar[XB_XGEN(b.x)]) == gen, bar);
            __builtin_amdgcn_fence(__ATOMIC_ACQUIRE, "agent");
            asm volatile("s_waitcnt vmcnt(0)" ::: "memory");
        }
    }
    __syncthreads();
}
struct Args { const float* in[22]; float* out; unsigned char* ws; int ph_lo, ph_hi, li, pad; };
__device__ __forceinline__ float wave_sum(float v) {
#pragma unroll
    for (int o = 1; o < 64; o <<= 1) v += __shfl_xor(v, o);
    return v;
}
__device__ __forceinline__ float siluf(float x) { return x / (1.f + expf(-x)); }
__device__ __forceinline__ int ropeperm(int pp) { return 64 * ((pp >> 2) & 1) + 16 * (pp >> 5) + 4 * ((pp >> 3) & 3) + (pp & 3); }
__device__ __forceinline__ int inproj_src(int pr, float& scale) {
    scale = 1.f; const int pn = pr >> 8, p = pr & 255;
    if (pn == 0) { scale = 0.125f; return p; }
    if (pn == 1) return 256 + p;
    if (pn <= 3) return 512 + (pn - 2) * 256 + p;
    if (pn <= 5) return 1024 + (pn - 4) * 256 + p;
    if (pn <= 7) return 1552 + (2 * (pn - 6) + (p >> 7)) * 128 + ropeperm(p & 127);
    if (pn == 8) return 2064 + (p >> 7) * 128 + ropeperm(p & 127);
    if (pn == 9) return 2320 + p;
    if (pn == 10) return 2576 + (p >> 7) * 128 + ropeperm(p & 127);
    if (pn == 11) return 2832 + p;
    if (pn == 12) return 3088 + (p >> 7) * 128 + ropeperm(p & 127);
    if (pn == 13) return 3344 + p;
    return p < 16 ? 1536 + p : (p < 28 ? 3600 + (p - 16) : -1);
}
template <int MODE>
__device__ __forceinline__ void transpose_item(const float* W, int ldw, int K, bf16* WT, int k0, int n0, LAS float* scr, int lane) {
    int src = n0 + (lane & 31); float sc = 1.f;
    if (MODE == 1) src = inproj_src(n0 + (lane & 31), sc);
#pragma unroll 8
    for (int i = 0; i < 32; ++i) { const int kk = 2 * i + (lane >> 5); float v = 0.f; if (src >= 0) v = W[(size_t)(k0 + kk) * ldw + src] * sc; scr[kk * 33 + (lane & 31)] = v; }
    LDS_WAIT(); asm volatile("" ::: "memory");
    const int c = lane & 7;
#pragma unroll
    for (int j = 0; j < 4; ++j) { const int n = (lane >> 3) + 8 * j; const LAS float* s = scr + (8 * c) * 33 + n;
        v4u o; o.x = pk2(s[0 * 33], s[1 * 33]); o.y = pk2(s[2 * 33], s[3 * 33]); o.z = pk2(s[4 * 33], s[5 * 33]); o.w = pk2(s[6 * 33], s[7 * 33]);
        *(GAS v4u*)(WT + (size_t)(n0 + n) * K + k0 + 8 * c) = o; }
    LDS_WAIT(); asm volatile("" ::: "memory");
}
__device__ __forceinline__ void norm_mod_row(const float* xrow, const float* g, const float* sc, const float* sh, bf16* orow, int lane) {
    const GAS f32x4* xr = (const GAS f32x4*)xrow + lane; f32x4 v[4]; float ss = 0.f;
#pragma unroll
    for (int j = 0; j < 4; ++j) { v[j] = xr[64 * j]; ss += (v[j].x * v[j].x + v[j].y * v[j].y) + (v[j].z * v[j].z + v[j].w * v[j].w); }
    const float rstd = 1.f / sqrtf(wave_sum(ss) * (1.f / DM) + RMS_EPS);
    GAS unsigned long long* o8 = (GAS unsigned long long*)orow + lane;
#pragma unroll
    for (int j = 0; j < 4; ++j) { const int col = 4 * (lane + 64 * j); const f32x4 gv = *(const f32x4*)(g + col), sv = *(const GAS f32x4*)(sc + col), hv = *(const GAS f32x4*)(sh + col);
        const f32x4 y = v[j] * rstd * gv * (sv + 1.0f) + hv;
        o8[64 * j] = (unsigned long long)pk2(y.x, y.y) | ((unsigned long long)pk2(y.z, y.w) << 32); }
}

__device__ __forceinline__ void phase0(const Args& a, LAS unsigned char* lds, int tid, int lane, int wave, int vcu, int G, bool do_atomics) {
    unsigned char* ws = a.ws;
    { LAS float* sl = (LAS float*)lds;
      const float* c = a.in[1];
      for (int i = tid; i < 16 * 1024; i += NWAVES * 64) { const int b = i >> 10, k = i & 1023; sl[k * 16 + b] = siluf(c[i]); }
      __syncthreads();
      const int gt = (int)blockIdx.x * (NWAVES * 64) + tid;
      float* MOD = (float*)(ws + WS_MOD); float* PEB = (float*)(ws + WS_PEB);
      for (int id = gt; id < 6144 * 16 + 8192; id += G * NWAVES * 64) {
        if (id < 6144 * 16) { const int j = id % 6144, sli = id / 6144; const float* w = a.in[3] + (size_t)(sli * 64) * 6144 + j;
            float acc[16];
#pragma unroll
            for (int b = 0; b < 16; ++b) acc[b] = 0.f;
            for (int kk = 0; kk < 64; ++kk) { const float wv = w[(size_t)kk * 6144]; const LAS f32x4* sp = (const LAS f32x4*)(sl + (sli * 64 + kk) * 16);
#pragma unroll
                for (int q = 0; q < 4; ++q) { const f32x4 s4 = sp[q];
#pragma unroll
                    for (int i = 0; i < 4; ++i) acc[4 * q + i] += s4[i] * wv; } }
            const float bias = sli == 0 ? a.in[4][j] : 0.f;
#pragma unroll
            for (int b = 0; b < 16; ++b) if (do_atomics) atomicAdd(&MOD[b * 6144 + j], acc[b] + bias);
        } else { const int id2 = id - 6144 * 16, t = id2 >> 12, rem = id2 & 4095, j = rem & 255, sli = rem >> 8;
            const float* pe = a.in[10 + t] + sli * 256; const float* w1 = a.in[12 + 2 * t] + (size_t)(sli * 256) * 256 + j; float acc = 0.f;
            for (int kk = 0; kk < 256; ++kk) acc += pe[kk] * w1[(size_t)kk * 256];
            if (do_atomics) atomicAdd(&PEB[t * 256 + j], acc); }
      }
      __syncthreads(); }
    LAS float* scr = (LAS float*)(lds + wave * 16384);
    const int gw = vcu * NWAVES + wave, NGW = G * NWAVES;
    constexpr int I_IN = 16 * 120, I_O = 16 * 32, I_1 = 16 * 128, I_2 = 64 * 32, I_C = 64 * 8;
    for (int it = gw; it < I_IN + I_O + I_1 + I_2 + 2 * I_C; it += NGW) {
        int r = it;
        if (r < I_IN) { transpose_item<1>(a.in[6], DIN, DM, (bf16*)(ws + WS_WIN), 64 * (r / 120), 32 * (r % 120), scr, lane); continue; } r -= I_IN;
        if (r < I_O) { transpose_item<0>(a.in[17], DM, DM, (bf16*)(ws + WS_WO), 64 * (r / 32), 32 * (r % 32), scr, lane); continue; } r -= I_O;
        if (r < I_1) { transpose_item<0>(a.in[19], DFF, DM, (bf16*)(ws + WS_WFF1), 64 * (r / 128), 32 * (r % 128), scr, lane); continue; } r -= I_1;
        if (r < I_2) { transpose_item<0>(a.in[20], DM, DFF, (bf16*)(ws + WS_WFF2), 64 * (r / 32), 32 * (r % 32), scr, lane); continue; } r -= I_2;
        if (r < I_C) { transpose_item<0>(a.in[12], 256, 4096, (bf16*)(ws + WS_CKW1), 64 * (r / 8), 32 * (r % 8), scr, lane); continue; } r -= I_C;
        transpose_item<0>(a.in[14], 256, 4096, (bf16*)(ws + WS_CVW1), 64 * (r / 8), 32 * (r % 8), scr, lane);
    }
    { const int* pos = (const int*)a.in[2]; float* tab = (float*)(ws + WS_TAB);
      const float inv = exp2f(-(float)lane * (13.287712379549449f / 64.f));
      for (int m = gw; m < MTOK; m += NGW) { const float ang = (float)pos[m] * inv; double rev = (double)ang * 0.15915494309189535; rev -= rint(rev);
          const float r = (float)rev; typedef float f32x2 __attribute__((ext_vector_type(2)));
          *(GAS f32x2*)(tab + ((size_t)m * 64 + lane) * 2) = (f32x2){__builtin_amdgcn_cosf(r), __builtin_amdgcn_sinf(r)}; } }
}
__device__ __forceinline__ void gla_scalar_item(const Args& a, int item, int lane, LAS float* sq) {
    LAS float* sk = sq + 4096; LAS float* sa = sq + 8192; LAS float* sv = sq + 12288;
    const int bh = item >> 1, b = bh >> 2, h = bh & 3, e = (item & 1) * 64 + lane;
    const bf16* gla = (const bf16*)(a.ws + WS_GLA); const float* rg = (const float*)(a.ws + WS_RG); bf16* mix = (bf16*)(a.ws + WS_XN);
    float wa[16];
#pragma unroll
    for (int r = 0; r < 16; ++r) wa[r] = a.in[7][r * 256 + h * 64 + lane];
    const float ba = a.in[8][h * 64 + lane];
    float S[64];
#pragma unroll
    for (int d = 0; d < 64; ++d) S[d] = 0.f;
    for (int c = 0; c < 32; ++c) { const size_t m0 = (size_t)b * SEQ + c * 64;
#pragma unroll 4
        for (int tt = 0; tt < 64; ++tt) { const size_t m = m0 + tt;
            const float q = bf2f(gla[m * 1536 + h * 64 + lane]), k = bf2f(gla[m * 1536 + 256 + h * 64 + lane]), v = bf2f(gla[m * 1536 + 512 + h * 128 + e]);
            const float grv = rg[m * 32 + (lane & 15)]; float z = ba;
#pragma unroll
            for (int r = 0; r < 16; ++r) z += __shfl(grv, r) * wa[r];
            const float ls = fminf(z, 0.f) - log1pf(expf(-fabsf(z)));
            sq[tt * 64 + lane] = q; sk[tt * 64 + lane] = k; sa[tt * 64 + lane] = expf(ls * (1.f / 16.f)); sv[tt * 64 + lane] = v; }
        LDS_WAIT(); asm volatile("" ::: "memory");
        for (int tt = 0; tt < 64; ++tt) { const float v = sv[tt * 64 + lane]; float o = 0.f;
#pragma unroll
            for (int d4 = 0; d4 < 16; ++d4) { const f32x4 q4 = *(const LAS f32x4*)(sq + tt * 64 + 4 * d4), k4 = *(const LAS f32x4*)(sk + tt * 64 + 4 * d4), a4 = *(const LAS f32x4*)(sa + tt * 64 + 4 * d4);
#pragma unroll
                for (int i = 0; i < 4; ++i) { S[4 * d4 + i] = a4[i] * S[4 * d4 + i] + k4[i] * v; o += q4[i] * S[4 * d4 + i]; } }
            mix[(m0 + tt) * 1024 + h * 128 + e] = (bf16)f2bf(o); }
        LDS_WAIT(); asm volatile("" ::: "memory"); }
}
namespace gla {
typedef unsigned short bf16_t;
typedef short bf16x8 __attribute__((ext_vector_type(8)));
typedef short s16x4 __attribute__((ext_vector_type(4)));
typedef float f32x16 __attribute__((ext_vector_type(16)));
typedef float f32x4 __attribute__((ext_vector_type(4)));
typedef unsigned u32x4 __attribute__((ext_vector_type(4)));
typedef unsigned u32x2 __attribute__((ext_vector_type(2)));
constexpr int G_QIN = 0, G_KIN = 8192, G_KDT = 16384, G_V = 24576, G_O = 40960, OPITCH = 132, G_WA = G_O + 64 * OPITCH * 4, G_BA = G_WA + 4096, G_SEG = G_BA + 256, G_DEC = G_SEG + 2048, G_END = G_DEC + 256;
#define GL_LAS __attribute__((address_space(3)))
typedef float f32x2_t __attribute__((ext_vector_type(2))); typedef __bf16 bf16x2_t __attribute__((ext_vector_type(2)));
__device__ __forceinline__ unsigned cvtpk_s(float lo, float hi) { f32x2_t v = {lo, hi}; bf16x2_t b = __builtin_convertvector(v, bf16x2_t); return __builtin_bit_cast(unsigned, b); }
__device__ __forceinline__ float blo(unsigned w) { return __builtin_bit_cast(float, w << 16); }
__device__ __forceinline__ float bhi(unsigned w) { return __builtin_bit_cast(float, w & 0xffff0000u); }
__device__ __forceinline__ int crow(int r, int hi) { return (r & 3) + 8 * (r >> 2) + 4 * hi; }
__device__ __forceinline__ int v_st(int k, int c) { const int kk = (k & ~0xC) | ((k & 4) << 1) | ((k & 8) >> 1); return ((kk >> 3) * 4 + (c >> 5)) * 512 + ((kk & 7) * 32 + (c & 31)) * 2; }
__device__ __forceinline__ int v_rd_base(int lane) { return ((lane & 3) << 3) | (((lane >> 2) & 3) << 6) | (((lane >> 4) & 1) << 5) | (((lane >> 5) & 1) << 8); }
#define MFMA32(a, b, c) __builtin_amdgcn_mfma_f32_32x32x16_bf16((a), (b), (c), 0, 0, 0)
#define PK4G(P, B_, OUT) do { unsigned a0 = cvtpk_s(P[B_+0], P[B_+1]), a1 = cvtpk_s(P[B_+2], P[B_+3]), b0 = cvtpk_s(P[B_+4], P[B_+5]), b1 = cvtpk_s(P[B_+6], P[B_+7]);   \
        auto r0 = __builtin_amdgcn_permlane32_swap(a0, b0, false, false); auto r1 = __builtin_amdgcn_permlane32_swap(a1, b1, false, false);                     \
        u32x4 w = {r0[0], r1[0], r0[1], r1[1]}; OUT = __builtin_bit_cast(bf16x8, w); } while (0)

struct Pre { u32x4 q, k, va, vb, ga, gb; f32x4 r0, r1, r2, r3; };
__device__ __forceinline__ void load_pre(Pre& P, const bf16_t* gla, const float* rg, size_t m, int h, int dc) {
    const bf16_t* row = gla + m * 1536;
    P.q = *(const u32x4*)(row + h * 64 + 8 * dc); P.k = *(const u32x4*)(row + 256 + h * 64 + 8 * dc);
    P.va = *(const u32x4*)(row + 512 + h * 128 + 16 * dc); P.vb = *(const u32x4*)(row + 512 + h * 128 + 16 * dc + 8);
    P.ga = *(const u32x4*)(row + 1024 + h * 128 + 16 * dc); P.gb = *(const u32x4*)(row + 1024 + h * 128 + 16 * dc + 8);
    const f32x4* rp = (const f32x4*)(rg + m * 32); P.r0 = rp[0]; P.r1 = rp[1]; P.r2 = rp[2]; P.r3 = rp[3];
}

__device__ __forceinline__ void gla_unit(int b, int h, const bf16_t* glabuf, const float* rg, const float* w_a2, const float* b_a, const float* norm_g, bf16_t* mix, GL_LAS unsigned char* lds) {
    int tid = threadIdx.x; asm volatile("" : "+v"(tid));
    const int lane = tid & 63, wid = __builtin_amdgcn_readfirstlane(tid >> 6), r32 = lane & 31, hi = lane >> 5, rb = wid >> 2, eq = wid & 3;
    const int t = tid >> 3, dc = tid & 7;
    GL_LAS float* WA = (GL_LAS float*)(lds + G_WA); GL_LAS float* BA = (GL_LAS float*)(lds + G_BA); GL_LAS float* SEG = (GL_LAS float*)(lds + G_SEG); GL_LAS float* DEC = (GL_LAS float*)(lds + G_DEC);
    GL_LAS float* OB = (GL_LAS float*)(lds + G_O);
    for (int i = tid; i < 16 * 64; i += 512) WA[i] = w_a2[(i >> 6) * 256 + h * 64 + (i & 63)];
    if (tid < 64) BA[tid] = b_a[h * 64 + tid];
    float gn[16];
#pragma unroll
    for (int i = 0; i < 16; ++i) gn[i] = norm_g[h * 128 + 16 * dc + i];
    f32x16 S0 = {}, S1 = {};
    const size_t mbase = (size_t)b * SEQ;
    Pre P; load_pre(P, glabuf, rg, mbase + t, h, dc);
    __syncthreads();
    for (int c = 0; c < 32; ++c) {
        float la[8];
        { float z[8];
          const GL_LAS f32x4* bp = (const GL_LAS f32x4*)(BA + 8 * dc); const f32x4 b0 = bp[0], b1 = bp[1];
          z[0] = b0[0]; z[1] = b0[1]; z[2] = b0[2]; z[3] = b0[3]; z[4] = b1[0]; z[5] = b1[1]; z[6] = b1[2]; z[7] = b1[3];
          const float g[16] = {P.r0[0], P.r0[1], P.r0[2], P.r0[3], P.r1[0], P.r1[1], P.r1[2], P.r1[3], P.r2[0], P.r2[1], P.r2[2], P.r2[3], P.r3[0], P.r3[1], P.r3[2], P.r3[3]};
#pragma unroll
          for (int r = 0; r < 16; ++r) { const GL_LAS f32x4* wp = (const GL_LAS f32x4*)(WA + r * 64 + 8 * dc); const f32x4 w0 = wp[0], w1 = wp[1];
              z[0] += g[r] * w0[0]; z[1] += g[r] * w0[1]; z[2] += g[r] * w0[2]; z[3] += g[r] * w0[3]; z[4] += g[r] * w1[0]; z[5] += g[r] * w1[1]; z[6] += g[r] * w1[2]; z[7] += g[r] * w1[3]; }
#pragma unroll
          for (int i = 0; i < 8; ++i) la[i] = (fminf(z[i], 0.f) - __logf(1.f + __expf(-fabsf(z[i])))) * (1.f / 16.f); }
#pragma unroll
        for (int off = 8; off < 64; off <<= 1) {
#pragma unroll
            for (int i = 0; i < 8; ++i) { const float u = __shfl_up(la[i], off); if (lane >= off) la[i] += u; } }
        if ((lane >> 3) == 7) { *(GL_LAS f32x4*)(SEG + wid * 64 + 8 * dc) = (f32x4){la[0], la[1], la[2], la[3]}; *(GL_LAS f32x4*)(SEG + wid * 64 + 8 * dc + 4) = (f32x4){la[4], la[5], la[6], la[7]}; }
        __syncthreads();
        float bl[8];
#pragma unroll
        for (int i = 0; i < 8; ++i) bl[i] = 0.f;
#pragma unroll
        for (int w = 0; w < 8; ++w) { const f32x4 s0 = *(const GL_LAS f32x4*)(SEG + w * 64 + 8 * dc), s1 = *(const GL_LAS f32x4*)(SEG + w * 64 + 8 * dc + 4);
            const float sv[8] = {s0[0], s0[1], s0[2], s0[3], s1[0], s1[1], s1[2], s1[3]};
#pragma unroll
            for (int i = 0; i < 8; ++i) { bl[i] += sv[i]; if (w < wid) la[i] += sv[i]; } }
        { const float qf[8] = {blo(P.q.x), bhi(P.q.x), blo(P.q.y), bhi(P.q.y), blo(P.q.z), bhi(P.q.z), blo(P.q.w), bhi(P.q.w)};
          const float kf[8] = {blo(P.k.x), bhi(P.k.x), blo(P.k.y), bhi(P.k.y), blo(P.k.z), bhi(P.k.z), blo(P.k.w), bhi(P.k.w)};
          float qi[8], ki[8], kd[8];
#pragma unroll
          for (int i = 0; i < 8; ++i) { qi[i] = qf[i] * __expf(la[i]); ki[i] = kf[i] * __expf(-la[i]); kd[i] = kf[i] * __expf(bl[i] - la[i]); }
          const int swz = ((dc ^ (t & 7)) << 4);
          *(GL_LAS u32x4*)(lds + G_QIN + t * 128 + swz) = (u32x4){cvtpk_s(qi[0], qi[1]), cvtpk_s(qi[2], qi[3]), cvtpk_s(qi[4], qi[5]), cvtpk_s(qi[6], qi[7])};
          *(GL_LAS u32x4*)(lds + G_KIN + t * 128 + swz) = (u32x4){cvtpk_s(ki[0], ki[1]), cvtpk_s(ki[2], ki[3]), cvtpk_s(ki[4], ki[5]), cvtpk_s(ki[6], ki[7])};
#pragma unroll
          for (int i = 0; i < 8; ++i) { const int d = 8 * dc + i; *(GL_LAS unsigned short*)(lds + G_KDT + d * 128 + (((t >> 3) ^ (d & 7)) << 4) + (t & 7) * 2) = (unsigned short)(cvtpk_s(kd[i], 0.f) & 0xffffu); }
          if (t == 0) { *(GL_LAS f32x4*)(DEC + 8 * dc) = (f32x4){__expf(bl[0]), __expf(bl[1]), __expf(bl[2]), __expf(bl[3])}; *(GL_LAS f32x4*)(DEC + 8 * dc + 4) = (f32x4){__expf(bl[4]), __expf(bl[5]), __expf(bl[6]), __expf(bl[7])}; }
          *(GL_LAS u32x4*)(lds + G_V + v_st(t, 16 * dc)) = P.va; *(GL_LAS u32x4*)(lds + G_V + v_st(t, 16 * dc + 8)) = P.vb; }
        const u32x4 ga = P.ga, gb = P.gb;
        if (c + 1 < 32) load_pre(P, glabuf, rg, mbase + (size_t)(c + 1) * 64 + t, h, dc);
        __syncthreads();
        { const int crw = 32 * rb + r32;
          f32x16 p0 = {}, p1 = {};
#pragma unroll
          for (int d0 = 0; d0 < 4; ++d0) { const int ch = 2 * d0 + hi;
              const bf16x8 qv = *(const GL_LAS bf16x8*)(lds + G_QIN + crw * 128 + ((ch ^ (crw & 7)) << 4));
              const bf16x8 k0 = *(const GL_LAS bf16x8*)(lds + G_KIN + r32 * 128 + ((ch ^ (r32 & 7)) << 4));
              p0 = MFMA32(k0, qv, p0);
              if (rb) { const bf16x8 k1 = *(const GL_LAS bf16x8*)(lds + G_KIN + (32 + r32) * 128 + ((ch ^ (r32 & 7)) << 4)); p1 = MFMA32(k1, qv, p1); } }
#pragma unroll
          for (int r = 0; r < 16; ++r) { const bool keep = crow(r, hi) <= r32; if (rb) p1[r] = keep ? p1[r] : 0.f; else p0[r] = keep ? p0[r] : 0.f; }
          bf16x8 pa0, pa1, pa2, pa3; PK4G(p0, 0, pa0); PK4G(p0, 8, pa1); PK4G(p1, 0, pa2); PK4G(p1, 8, pa3);
          const int vb = G_V + v_rd_base(lane) + eq * 512; bf16x8 vf[4];
#pragma unroll
          for (int ks = 0; ks < 4; ++ks) { const s16x4 lo = __builtin_bit_cast(s16x4, __builtin_amdgcn_ds_read_tr16_b64_v4i16((GL_LAS s16x4*)(lds + vb + ks * 4096)));
              const s16x4 hh = __builtin_bit_cast(s16x4, __builtin_amdgcn_ds_read_tr16_b64_v4i16((GL_LAS s16x4*)(lds + vb + ks * 4096 + 2048)));
              vf[ks] = (bf16x8){lo[0], lo[1], lo[2], lo[3], hh[0], hh[1], hh[2], hh[3]}; }
          f32x16 o = {};
          o = MFMA32(pa0, vf[0], o); o = MFMA32(pa1, vf[1], o);
          if (rb) { o = MFMA32(pa2, vf[2], o); o = MFMA32(pa3, vf[3], o); }
#pragma unroll
          for (int s = 0; s < 4; ++s) {
              const u32x2 a_lo = *(const GL_LAS u32x2*)(lds + G_QIN + crw * 128 + (((2 * s) ^ (crw & 7)) << 4) + 8 * hi);
              const u32x2 a_hi = *(const GL_LAS u32x2*)(lds + G_QIN + crw * 128 + (((2 * s + 1) ^ (crw & 7)) << 4) + 8 * hi);
              const u32x4 aw = {a_lo.x, a_lo.y, a_hi.x, a_hi.y};
              u32x4 bw;
              if (s == 0) bw = (u32x4){cvtpk_s(S0[0], S0[1]), cvtpk_s(S0[2], S0[3]), cvtpk_s(S0[4], S0[5]), cvtpk_s(S0[6], S0[7])};
              else if (s == 1) bw = (u32x4){cvtpk_s(S0[8], S0[9]), cvtpk_s(S0[10], S0[11]), cvtpk_s(S0[12], S0[13]), cvtpk_s(S0[14], S0[15])};
              else if (s == 2) bw = (u32x4){cvtpk_s(S1[0], S1[1]), cvtpk_s(S1[2], S1[3]), cvtpk_s(S1[4], S1[5]), cvtpk_s(S1[6], S1[7])};
              else bw = (u32x4){cvtpk_s(S1[8], S1[9]), cvtpk_s(S1[10], S1[11]), cvtpk_s(S1[12], S1[13]), cvtpk_s(S1[14], S1[15])};
              o = MFMA32(__builtin_bit_cast(bf16x8, aw), __builtin_bit_cast(bf16x8, bw), o); }
#pragma unroll
          for (int rq = 0; rq < 4; ++rq) { const f32x4 d0v = *(const GL_LAS f32x4*)(DEC + 8 * rq + 4 * hi), d1v = *(const GL_LAS f32x4*)(DEC + 32 + 8 * rq + 4 * hi);
#pragma unroll
              for (int i = 0; i < 4; ++i) { S0[4 * rq + i] *= d0v[i]; S1[4 * rq + i] *= d1v[i]; } }
#pragma unroll
          for (int ks = 0; ks < 4; ++ks) { const int ch = 2 * ks + hi;
              const bf16x8 a0 = *(const GL_LAS bf16x8*)(lds + G_KDT + r32 * 128 + ((ch ^ (r32 & 7)) << 4));
              const bf16x8 a1 = *(const GL_LAS bf16x8*)(lds + G_KDT + (32 + r32) * 128 + ((ch ^ (r32 & 7)) << 4));
              S0 = MFMA32(a0, vf[ks], S0); S1 = MFMA32(a1, vf[ks], S1); }
#pragma unroll
          for (int r = 0; r < 16; ++r) OB[(32 * rb + crow(r, hi)) * OPITCH + 32 * eq + r32] = o[r]; }
        __syncthreads();
        { const GL_LAS f32x4* op = (const GL_LAS f32x4*)(OB + t * OPITCH + 16 * dc); const f32x4 o0 = op[0], o1 = op[1], o2 = op[2], o3 = op[3];
          const float ov[16] = {o0[0], o0[1], o0[2], o0[3], o1[0], o1[1], o1[2], o1[3], o2[0], o2[1], o2[2], o2[3], o3[0], o3[1], o3[2], o3[3]};
          float ss = 0.f;
#pragma unroll
          for (int i = 0; i < 16; ++i) ss += ov[i] * ov[i];
          ss += __shfl_xor(ss, 1); ss += __shfl_xor(ss, 2); ss += __shfl_xor(ss, 4);
          const float rstd = 1.f / sqrtf(ss * (1.f / 128.f) + RMS_EPS);
          const float gg[16] = {blo(ga.x), bhi(ga.x), blo(ga.y), bhi(ga.y), blo(ga.z), bhi(ga.z), blo(ga.w), bhi(ga.w), blo(gb.x), bhi(gb.x), blo(gb.y), bhi(gb.y), blo(gb.z), bhi(gb.z), blo(gb.w), bhi(gb.w)};
          float y[16];
#pragma unroll
          for (int i = 0; i < 16; ++i) y[i] = ov[i] * rstd * gn[i] * (gg[i] / (1.f + __expf(-gg[i])));
          bf16_t* orow = mix + (mbase + (size_t)c * 64 + t) * 1024 + h * 128 + 16 * dc;
          *(u32x4*)orow = (u32x4){cvtpk_s(y[0], y[1]), cvtpk_s(y[2], y[3]), cvtpk_s(y[4], y[5]), cvtpk_s(y[6], y[7])};
          *(u32x4*)(orow + 8) = (u32x4){cvtpk_s(y[8], y[9]), cvtpk_s(y[10], y[11]), cvtpk_s(y[12], y[13]), cvtpk_s(y[14], y[15])}; }
    }
    __syncthreads();
}
#undef PK4G
#undef MFMA32
}
__device__ __forceinline__ int q_next(gu32* ctr, volatile LAS unsigned* slot) {
    __syncthreads();
    if (threadIdx.x == 0) *slot = __hip_atomic_fetch_add(ctr, 1u, RLX_AGENT);
    __syncthreads();
    return __builtin_amdgcn_readfirstlane((int)*slot);
}
__global__ void __launch_bounds__(NWAVES * 64, 2) fwd_kernel(Args args) {
    extern __shared__ __attribute__((aligned(16))) unsigned char lds_g[];
    LAS unsigned char* lds = (LAS unsigned char*)lds_g;
    volatile LAS unsigned* MISC = (volatile LAS unsigned*)(lds + MISC_OFF);
#define PHASE_IDS() int tid = threadIdx.x; asm volatile("" : "+v"(tid)); const int lane = tid & 63, wave = __builtin_amdgcn_readfirstlane(tid >> 6); const int gw = vcu * NWAVES + wave, NGW = G * NWAVES; (void)lane; (void)gw; (void)NGW;
    const int G = gridDim.x; const int bx = blockIdx.x; const int vcu = (G % 8 == 0) ? (bx % 8) * (G / 8) + bx / 8 : bx;
    unsigned char* ws = args.ws; gu32* ctl = (gu32*)(ws + WS_CTL);
    for (int u = threadIdx.x; u < (LDS_BYTES - LDSCTL_OFF) / 4; u += NWAVES * 64) ((LAS unsigned*)(lds + LDSCTL_OFF))[u] = 0u;
    __syncthreads();
    XcdBarrier bar; bar.bar = (unsigned*)(ctl + CW_BAR) + args.li * XCD_BAR_WORDS; bar.x = 0; bar.st = nullptr;
    if (N_LAUNCHES != N_PHASES) bar = xcd_barrier_post((unsigned*)(ctl + CW_BAR) + args.li * XCD_BAR_WORDS, MISC + 8);
    const int lo = args.ph_lo, hi = args.ph_hi;
#ifndef PH_MASK
#define PH_MASK 0xfff
#endif
#define IN(k) (((PH_MASK >> (k)) & 1) && lo <= (k) && (k) < hi)
#define SEAM(k) do { if (IN(k) && IN((k) + 1)) xcd_barrier(bar); } while (0)
#ifndef PROBE_DUP
#define PROBE_DUP -1
#endif
    float* MOD = (float*)(ws + WS_MOD);
    bf16* XN = (bf16*)(ws + WS_XN);

    if (IN(0)) for (int rep = 0; rep < (PROBE_DUP == 0 ? 2 : 1); ++rep) { PHASE_IDS(); phase0(args, lds, tid, lane, wave, vcu, G, rep == 0); } SEAM(0);
    if (IN(1)) for (int rep = 0; rep < (PROBE_DUP == 1 ? 2 : 1); ++rep) { PHASE_IDS(); for (int m = gw; m < MTOK; m += NGW) { const int b = m / SEQ; norm_mod_row(args.in[0] + (size_t)m * DM, args.in[5], MOD + b * NMOD + 1024, MOD + b * NMOD, XN + (size_t)m * DM, lane); } } SEAM(1);
    if (IN(2)) for (int rep = 0; rep < (PROBE_DUP == 2 ? 2 : 1); ++rep) { PHASE_IDS(); pg8::Gemm g{XN, (const bf16*)(ws + WS_WIN), MTOK, NPROJ, DM, DM}; pg8::StaticOrder S; S.init(MTOK, NPROJ, G, bx);
        pg8::EpiInProj E{(bf16*)(ws + WS_GLA), (bf16*)(ws + WS_NQ), (bf16*)(ws + WS_KV), KV_STRIDE_B / 2, (float*)(ws + WS_RG), (const float*)(ws + WS_TAB)};
        pg8::gemm_phase<pg8::EpiInProj, pg8::StaticOrder, true, true>(lds, g, S, E); } SEAM(2);
#ifndef GLA_MFMA
#define GLA_MFMA 1
#endif
#ifndef NSA_PARTS
#define NSA_PARTS 7
#endif
#define NSA_TASK_VARS const int qb = 15 - (id >> 5), bh = id & 31, b = bh >> 1, hk = bh & 1, P0 = qb * 128; \
                const bf16* Qw = NQ + ((size_t)(b * 4 + 2 * hk + g) * SEQ + P0 + qrel) * 128; \
                bf16* Ow = (bf16*)(ws + WS_OBR) + (size_t)(b * SEQ + P0 + qrel) * 512 + (2 * hk + g) * 128; \
                const size_t kvo = (size_t)bh * SEQ * 128; unsigned* selg = (unsigned*)(ws + WS_SEL) + (size_t)bh * SEQ + P0; (void)kvo; (void)Ow; (void)Qw; (void)selg;
    if (IN(3)) for (int rep = 0; rep < (PROBE_DUP == 3 ? 2 : 1); ++rep) { PHASE_IDS();
        if (bx < 32) { const int t = bx >> 4;
            pg8::Gemm g{(const bf16*)(ws + WS_KV + (size_t)t * KV_STRIDE_B), (const bf16*)(ws + (t ? WS_CVW1 : WS_CKW1)), 4096, 256, 4096, 2048}; pg8::OneUnit S{bx & 15, 0};
            pg8::EpiActBf16<1> E{(bf16*)(ws + WS_HID) + (size_t)t * 4096 * 256, 256, (const float*)(ws + WS_PEB) + t * 256};
            pg8::gemm_phase<pg8::EpiActBf16<1>, pg8::OneUnit, true, true>(lds, g, S, E); }
        const bf16* NQ = (const bf16*)(ws + WS_NQ); const int g = wave >> 2, qrel = 32 * (wave & 3);
        if (NSA_PARTS & 4) for (;;) { const int id = q_next(ctl + CW_QW + 64 * rep, MISC + 16); if (id >= 512) break; NSA_TASK_VARS
            nsa::attn_branch<false>(Qw, (const bf16*)(ws + WS_KV + 4 * KV_STRIDE_B) + kvo, (const bf16*)(ws + WS_KV + 5 * KV_STRIDE_B) + kvo, Ow + OBR_STRIDE_B, 512, P0, qrel, 512, nullptr, (char*)lds_g); }
    } SEAM(3);
    if (IN(4)) for (int rep = 0; rep < (PROBE_DUP == 4 ? 2 : 1); ++rep) { PHASE_IDS(); LAS float* hrow = (LAS float*)(lds + wave * 4096);
        for (int item = gw; item < 2048; item += NGW) { const int t = item >> 10, m0 = (item & 1023) * 4;
#pragma unroll
            for (int r = 0; r < 4; ++r) { const v2u hv = *(const GAS v2u*)((const bf16*)(ws + WS_HID) + ((size_t)t * 4096 + m0 + r) * 256 + 4 * lane);
                *(LAS f32x4*)(hrow + r * 256 + 4 * lane) = (f32x4){bflo(hv.x), bfhi(hv.x), bflo(hv.y), bfhi(hv.y)}; }
            LDS_WAIT(); asm volatile("" ::: "memory");
            const float* w2 = args.in[13 + 2 * t]; float a0[4] = {0.f, 0.f, 0.f, 0.f}, a1[4] = {0.f, 0.f, 0.f, 0.f};
#pragma unroll 2
            for (int j4 = 0; j4 < 64; ++j4) { f32x4 h4[4];
#pragma unroll
                for (int r = 0; r < 4; ++r) h4[r] = *(const LAS f32x4*)(hrow + r * 256 + 4 * j4);
#pragma unroll
                for (int i = 0; i < 4; ++i) { const float wa = w2[(4 * j4 + i) * 128 + lane], wb = w2[(4 * j4 + i) * 128 + 64 + lane];
#pragma unroll
                    for (int r = 0; r < 4; ++r) { a0[r] += h4[r][i] * wa; a1[r] += h4[r][i] * wb; } } }
#pragma unroll
            for (int r = 0; r < 4; ++r) { bf16* o = (bf16*)(ws + (t ? WS_VCMP : WS_KCMP)) + (size_t)(m0 + r) * 128; o[lane] = (bf16)f2bf(a0[r]); o[64 + lane] = (bf16)f2bf(a1[r]); }
            LDS_WAIT(); asm volatile("" ::: "memory"); } } SEAM(4);
    if (IN(5)) for (int rep = 0; rep < (PROBE_DUP == 5 ? 2 : 1); ++rep) { PHASE_IDS();
        if (GLA_MFMA && bx < 64) gla::gla_unit(bx >> 2, bx & 3, (const bf16*)(ws + WS_GLA), (const float*)(ws + WS_RG), args.in[7], args.in[8], args.in[9], XN, lds);
        const bf16* NQ = (const bf16*)(ws + WS_NQ); const int g = wave >> 2, qrel = 32 * (wave & 3);
        for (;;) { const int id = q_next(ctl + CW_QS + 64 * rep, MISC + 16); if (id >= 512) break; NSA_TASK_VARS
            if (NSA_PARTS & 1) nsa::cmp_branch(Qw, (const bf16*)(ws + WS_KCMP) + (size_t)bh * 128 * 128, (const bf16*)(ws + WS_VCMP) + (size_t)bh * 128 * 128, Ow, 512, P0, qrel, g, selg, (char*)lds_g);
            if (NSA_PARTS & 2) nsa::attn_branch<true>(Qw, (const bf16*)(ws + WS_KV + 2 * KV_STRIDE_B) + kvo, (const bf16*)(ws + WS_KV + 3 * KV_STRIDE_B) + kvo, Ow + OBR_STRIDE_B / 2, 512, P0, qrel, 0x40000000, selg, (char*)lds_g); }
    } SEAM(5);
    if (IN(6)) for (int rep = 0; rep < (PROBE_DUP == 6 ? 2 : 1); ++rep) { PHASE_IDS(); const bf16* OBR = (const bf16*)(ws + WS_OBR); const float* rg = (const float*)(ws + WS_RG); const bf16* gla = (const bf16*)(ws + WS_GLA);
        for (int m = gw; m < MTOK; m += NGW) { const int hq = lane >> 4; float gt[3];
#pragma unroll
            for (int br = 0; br < 3; ++br) { const float z = rg[(size_t)m * 32 + 16 + hq * 3 + br]; gt[br] = 1.f / (1.f + expf(-z)); }
            float o[8];
#pragma unroll
            for (int i = 0; i < 8; ++i) o[i] = 0.f;
#pragma unroll
            for (int br = 0; br < 3; ++br) { const v4u w = *(const GAS v4u*)(OBR + (size_t)br * (OBR_STRIDE_B / 2) + (size_t)m * 512 + 8 * lane);
                o[0] += gt[br] * bflo(w.x); o[1] += gt[br] * bfhi(w.x); o[2] += gt[br] * bflo(w.y); o[3] += gt[br] * bfhi(w.y);
                o[4] += gt[br] * bflo(w.z); o[5] += gt[br] * bfhi(w.z); o[6] += gt[br] * bflo(w.w); o[7] += gt[br] * bfhi(w.w); }
            float ss = 0.f;
#pragma unroll
            for (int i = 0; i < 8; ++i) ss += o[i] * o[i];
            const float rstd = 1.f / sqrtf(wave_sum(ss) * (1.f / 512.f) + RMS_EPS);
            const f32x4 g0 = *(const f32x4*)(args.in[16] + 8 * lane), g1 = *(const f32x4*)(args.in[16] + 8 * lane + 4);
            v4u w; w.x = pk2(o[0] * rstd * g0[0], o[1] * rstd * g0[1]); w.y = pk2(o[2] * rstd * g0[2], o[3] * rstd * g0[3]);
            w.z = pk2(o[4] * rstd * g1[0], o[5] * rstd * g1[1]); w.w = pk2(o[6] * rstd * g1[2], o[7] * rstd * g1[3]);
            *(GAS v4u*)(XN + (size_t)m * DM + 512 + 8 * lane) = w;
            if (!GLA_MFMA) {
            const v4u r = *(const GAS v4u*)(XN + (size_t)m * DM + 8 * lane); const v4u gg = *(const GAS v4u*)(gla + (size_t)m * 1536 + 1024 + 8 * lane);
            float v[8] = {bflo(r.x), bfhi(r.x), bflo(r.y), bfhi(r.y), bflo(r.z), bfhi(r.z), bflo(r.w), bfhi(r.w)};
            float q[8] = {bflo(gg.x), bfhi(gg.x), bflo(gg.y), bfhi(gg.y), bflo(gg.z), bfhi(gg.z), bflo(gg.w), bfhi(gg.w)};
            float s2 = 0.f;
#pragma unroll
            for (int i = 0; i < 8; ++i) s2 += v[i] * v[i];
            s2 += __shfl_xor(s2, 1); s2 += __shfl_xor(s2, 2); s2 += __shfl_xor(s2, 4); s2 += __shfl_xor(s2, 8);
            const float rs2 = 1.f / sqrtf(s2 * (1.f / 128.f) + RMS_EPS);
            const f32x4 h0 = *(const f32x4*)(args.in[9] + 8 * lane), h1 = *(const f32x4*)(args.in[9] + 8 * lane + 4);
            float y[8];
#pragma unroll
            for (int i = 0; i < 8; ++i) y[i] = v[i] * rs2 * (i < 4 ? h0[i & 3] : h1[i & 3]) * siluf(q[i]);
            v4u w2; w2.x = pk2(y[0], y[1]); w2.y = pk2(y[2], y[3]); w2.z = pk2(y[4], y[5]); w2.w = pk2(y[6], y[7]);
            *(GAS v4u*)(XN + (size_t)m * DM + 8 * lane) = w2; } } } SEAM(6);
    if (IN(7)) for (int rep = 0; rep < (PROBE_DUP == 7 ? 2 : 1); ++rep) { PHASE_IDS(); pg8::Gemm g{XN, (const bf16*)(ws + WS_WO), MTOK, DM, DM, DM}; pg8::StaticOrder S; S.init(MTOK, DM, G, bx);
        pg8::EpiResid E{args.in[0], args.out, MOD + 2048};
        pg8::gemm_phase<pg8::EpiResid, pg8::StaticOrder, true, true>(lds, g, S, E); } SEAM(7);
    if (IN(8)) for (int rep = 0; rep < (PROBE_DUP == 8 ? 2 : 1); ++rep) { PHASE_IDS(); for (int m = gw; m < MTOK; m += NGW) { const int b = m / SEQ; norm_mod_row(args.out + (size_t)m * DM, args.in[18], MOD + b * NMOD + 4096, MOD + b * NMOD + 3072, XN + (size_t)m * DM, lane); } } SEAM(8);
    if (IN(9)) for (int rep = 0; rep < (PROBE_DUP == 9 ? 2 : 1); ++rep) { PHASE_IDS(); pg8::Gemm g{XN, (const bf16*)(ws + WS_WFF1), MTOK, DFF, DM, DM}; pg8::StaticOrder S; S.init(MTOK, DFF, G, bx);
        pg8::EpiActBf16<2> E{(bf16*)(ws + WS_H), DFF, nullptr};
        pg8::gemm_phase<pg8::EpiActBf16<2>, pg8::StaticOrder, true, true>(lds, g, S, E); } SEAM(9);
    if (IN(10)) { PHASE_IDS(); pg8::Gemm g{(const bf16*)(ws + WS_H), (const bf16*)(ws + WS_WFF2), MTOK, DM, DFF, DFF}; pg8::StaticOrder S; S.init(MTOK, DM, G, bx);
        pg8::EpiResid E{args.out, args.out, MOD + 5120};
        pg8::gemm_phase<pg8::EpiResid, pg8::StaticOrder, true, true>(lds, g, S, E); } SEAM(10);
    if (IN(11)) { PHASE_IDS(); for (int m = gw; m < MTOK; m += NGW) { GAS f32x4* xr = (GAS f32x4*)(args.out + (size_t)m * DM) + lane; f32x4 v[4]; float ss = 0.f;
#pragma unroll
            for (int j = 0; j < 4; ++j) { v[j] = xr[64 * j]; ss += (v[j].x * v[j].x + v[j].y * v[j].y) + (v[j].z * v[j].z + v[j].w * v[j].w); }
            const float rstd = 1.f / sqrtf(wave_sum(ss) * (1.f / DM) + RMS_EPS);
#pragma unroll
            for (int j = 0; j < 4; ++j) xr[64 * j] = v[j] * rstd * *(const f32x4*)(args.in[21] + 4 * (lane + 64 * j)); } }
#undef IN
#undef SEAM
}

extern "C" void kernel_launch(void* const* d_in, const int* in_sizes, int n_in, void* d_out, int out_size, void* d_ws, size_t ws_size, hipStream_t stream) {
    static int grid = 0;
    if (grid == 0) {
        if (n_in != 22 || in_sizes[0] != MTOK * DM || out_size != MTOK * DM || ws_size < WS_END) { fprintf(stderr, "kernel_launch: unexpected shapes (n_in %d, in0 %d, out %d, ws %zu)\n", n_in, n_in > 0 ? in_sizes[0] : -1, out_size, ws_size); grid = -1; return; }
        if (hipFuncSetAttribute((const void*)fwd_kernel, hipFuncAttributeMaxDynamicSharedMemorySize, LDS_BYTES) != hipSuccess) { fprintf(stderr, "kernel_launch: hipFuncSetAttribute failed\n"); grid = -1; return; }
        int per_cu = 0;
        if (hipOccupancyMaxActiveBlocksPerMultiprocessor(&per_cu, (const void*)fwd_kernel, NWAVES * 64, LDS_BYTES) != hipSuccess || per_cu < 1) fprintf(stderr, "kernel_launch: occupancy query reports %d workgroups per CU\n", per_cu);
        (void)hipGetLastError();
        grid = 256;
    }
    if (grid < 0) return;
    if (hipMemsetAsync((char*)d_ws + WS_CTL, 0, CTL_ZERO_BYTES, stream) != hipSuccess) { fprintf(stderr, "kernel_launch: hipMemsetAsync failed\n"); return; }
    Args a{};
    for (int i = 0; i < 22; ++i) a.in[i] = (const float*)d_in[i];
    a.out = (float*)d_out; a.ws = (unsigned char*)d_ws;
    for (int li = 0; li < N_LAUNCHES; ++li) {
        a.ph_lo = (N_LAUNCHES == 1) ? 0 : li; a.ph_hi = (N_LAUNCHES == 1) ? N_PHASES : li + 1; a.li = (N_LAUNCHES == 1) ? 0 : 0;
        hipLaunchKernelGGL(fwd_kernel, dim3(grid), dim3(NWAVES * 64), LDS_BYTES, stream, a);
        const hipError_t le = hipPeekAtLastError();
        if (le != hipSuccess) { fprintf(stderr, "kernel_launch: launch %d failed: %s\n", li, hipGetErrorName(le)); break; }
    }
}
```
